# Optimizing an MI355X kernel written in HIP

```python
import math
import jax, jax.numpy as jnp
from jax import lax
import numpy as np

D_MODEL = 1024
BATCH = 2
SEQ = 8192
DEPTH = 4

HEAD_DIM = 64
A_HEADS = D_MODEL // (4 * HEAD_DIM)
A_VDIM = 2 * HEAD_DIM
B_HEADS = D_MODEL // (2 * HEAD_DIM)
C_HEADS = D_MODEL // HEAD_DIM
Q_BLOCK = 128
N_GROUPS = 4
EXPERTS_PER_GROUP = 4
N_EXPERTS = N_GROUPS * EXPERTS_PER_GROUP
TOP_K = 2
D_EXPERT = D_MODEL
MOE_BLOCK = 128
EPS = 1e-6
N_EVEN = (DEPTH + 1) // 2
N_ODD = DEPTH // 2

kernel_name = 'hybrid_diff_stickbreak_fox_hmoe'


def rms_norm(x, g):
    xf = x.astype(jnp.float32)
    y = xf * lax.rsqrt(jnp.mean(xf * xf, axis=-1, keepdims=True) + EPS)
    return (y * g.astype(jnp.float32)).astype(x.dtype)


def to_heads(x, n, d):
    b, s, _ = x.shape
    return x.reshape(b, s, n, d).transpose(0, 2, 1, 3)


def from_heads(x):
    b, h, s, d = x.shape
    return x.transpose(0, 2, 1, 3).reshape(b, s, h * d)


def to_blocks(x):
    b, h, s = x.shape[:3]
    y = x.reshape((b, h, s // Q_BLOCK, Q_BLOCK) + x.shape[3:])
    return jnp.moveaxis(y, 2, 0)


def from_blocks(y):
    y = jnp.moveaxis(y, 0, 2)
    b, h, nb, q = y.shape[:4]
    return y.reshape((b, h, nb * q) + y.shape[4:])


def alibi_slopes(n):
    return np.array([2.0 ** (-8.0 * (i + 1) / n) for i in range(n)], dtype=np.float32)


def diff_attention(q1, q2, k1, k2, v, lam):
    s_len = q1.shape[2]
    scale = HEAD_DIM ** -0.5
    kpos = jnp.arange(s_len)
    slopes = jnp.asarray(alibi_slopes(A_HEADS))

    def block(args):
        qb1, qb2, i = args
        tpos = i * Q_BLOCK + jnp.arange(Q_BLOCK)
        dist = (tpos[:, None] - kpos[None, :]).astype(jnp.float32)
        causal = dist >= 0
        bias = -slopes[:, None, None] * dist

        def probs(qb, k):
            sc = jnp.einsum('bhqd,bhkd->bhqk', qb, k).astype(jnp.float32) * scale + bias
            return jax.nn.softmax(jnp.where(causal, sc, -jnp.inf), axis=-1)

        p = probs(qb1, k1) - lam * probs(qb2, k2)
        return jnp.einsum('bhqk,bhkd->bhqd', p.astype(v.dtype), v)

    nb = s_len // Q_BLOCK
    out = lax.map(block, (to_blocks(q1), to_blocks(q2), jnp.arange(nb)))
    return from_blocks(out)


def stick_breaking_attention(q, k, v):
    s_len = q.shape[2]
    scale = HEAD_DIM ** -0.5
    kpos = jnp.arange(s_len)

    def block(args):
        qb, i = args
        tpos = i * Q_BLOCK + jnp.arange(Q_BLOCK)
        before = tpos[:, None] > kpos[None, :]
        z = jnp.einsum('bhqd,bhkd->bhqk', qb, k).astype(jnp.float32) * scale
        log_beta = jax.nn.log_sigmoid(z)
        log_keep = jnp.where(before, jax.nn.log_sigmoid(-z), 0.0)
        acc = lax.cumsum(log_keep, axis=3, reverse=True) - log_keep
        w = jnp.where(before, jnp.exp(log_beta + acc), 0.0)
        return jnp.einsum('bhqk,bhkd->bhqd', w.astype(v.dtype), v)

    nb = s_len // Q_BLOCK
    out = lax.map(block, (to_blocks(q), jnp.arange(nb)))
    return from_blocks(out)


def forgetting_attention(q, k, v, cum_logf):
    s_len = q.shape[2]
    scale = HEAD_DIM ** -0.5
    kpos = jnp.arange(s_len)

    def block(args):
        qb, fb, i = args
        tpos = i * Q_BLOCK + jnp.arange(Q_BLOCK)
        causal = tpos[:, None] >= kpos[None, :]
        sc = jnp.einsum('bhqd,bhkd->bhqk', qb, k).astype(jnp.float32) * scale
        sc = sc + (fb[..., :, None] - cum_logf[..., None, :])
        p = jax.nn.softmax(jnp.where(causal, sc, -jnp.inf), axis=-1)
        return jnp.einsum('bhqk,bhkd->bhqd', p.astype(v.dtype), v)

    nb = s_len // Q_BLOCK
    out = lax.map(block, (to_blocks(q), to_blocks(cum_logf), jnp.arange(nb)))
    return from_blocks(out)


def even_mixer(h, w_in, q_gain, k_gain, lam_q1, lam_k1, lam_q2, lam_k2, subln_g, w_out, layer):
    b, s, _ = h.shape
    qa = A_HEADS * 2 * HEAD_DIM
    va = A_HEADS * A_VDIM
    qb = B_HEADS * HEAD_DIM
    cuts = list(np.cumsum([qa, qa, va, qb, qb]))
    proj = h @ w_in
    a_q, a_k, a_v, b_q, b_k, b_v = jnp.split(proj, cuts, axis=-1)
    a_q = rms_norm(a_q.reshape(b, s, A_HEADS, 2, HEAD_DIM), q_gain)
    a_k = rms_norm(a_k.reshape(b, s, A_HEADS, 2, HEAD_DIM), k_gain)
    q1 = a_q[..., 0, :].transpose(0, 2, 1, 3)
    q2 = a_q[..., 1, :].transpose(0, 2, 1, 3)
    k1 = a_k[..., 0, :].transpose(0, 2, 1, 3)
    k2 = a_k[..., 1, :].transpose(0, 2, 1, 3)
    lam_init = 0.8 - 0.6 * math.exp(-0.3 * layer)
    f32 = jnp.float32
    lam = (jnp.exp(jnp.sum(lam_q1.astype(f32) * lam_k1.astype(f32)))
           - jnp.exp(jnp.sum(lam_q2.astype(f32) * lam_k2.astype(f32))) + lam_init)
    o_a = diff_attention(q1, q2, k1, k2, to_heads(a_v, A_HEADS, A_VDIM), lam)
    o_a = rms_norm(o_a, subln_g) * (1.0 - lam_init)
    o_b = stick_breaking_attention(to_heads(b_q, B_HEADS, HEAD_DIM),
                                   to_heads(b_k, B_HEADS, HEAD_DIM),
                                   to_heads(b_v, B_HEADS, HEAD_DIM))
    o = jnp.concatenate([from_heads(o_a), from_heads(o_b)], axis=-1)
    return o @ w_out


def odd_mixer(h, w_in, b_f, q_gain, k_gain, w_out):
    b, s, _ = h.shape
    w = C_HEADS * HEAD_DIM
    proj = h @ w_in
    q, k, v, f = jnp.split(proj, [w, 2 * w, 3 * w], axis=-1)
    q = rms_norm(q.reshape(b, s, C_HEADS, HEAD_DIM), q_gain).transpose(0, 2, 1, 3)
    k = rms_norm(k.reshape(b, s, C_HEADS, HEAD_DIM), k_gain).transpose(0, 2, 1, 3)
    v = to_heads(v, C_HEADS, HEAD_DIM)
    log_f = jax.nn.log_sigmoid(f.astype(jnp.float32) + b_f.astype(jnp.float32))
    cum = jnp.cumsum(log_f, axis=1).transpose(0, 2, 1)
    o = forgetting_attention(q, k, v, cum)
    return from_heads(o) @ w_out


def hier_moe(h, w_group, b_group, w_router, b_router, w_gate, w_up, w_down):
    b, s, d = h.shape
    xt = h.reshape(-1, d)
    n = xt.shape[0]
    f32 = jnp.float32
    g_logits = (xt @ w_group).astype(f32) + b_group.astype(f32)
    g_probs = jax.nn.softmax(g_logits, axis=-1)
    g_idx = jnp.argmax(g_logits, axis=-1).astype(jnp.int32)
    g_w = jnp.take_along_axis(g_probs, g_idx[:, None], axis=1)
    e_logits = ((xt @ w_router).astype(f32) + b_router.astype(f32)).reshape(n, N_GROUPS, EXPERTS_PER_GROUP)
    e_in = jnp.take_along_axis(e_logits, g_idx[:, None, None], axis=1)[:, 0]
    top_v, top_i = lax.top_k(e_in, TOP_K)
    top_w = jax.nn.softmax(top_v, axis=-1) * g_w
    expert = g_idx[:, None] * EXPERTS_PER_GROUP + top_i.astype(jnp.int32)
    nk = n * TOP_K
    e_flat = expert.reshape(-1)
    w_flat = top_w.reshape(-1)
    tok_flat = jnp.arange(nk, dtype=jnp.int32) // TOP_K
    order = jnp.argsort(e_flat)
    e_sorted = e_flat[order]
    counts = jnp.bincount(e_flat, length=N_EXPERTS)
    starts = jnp.cumsum(counts) - counts
    padded = (counts + MOE_BLOCK - 1) // MOE_BLOCK * MOE_BLOCK
    pad_ends = jnp.cumsum(padded)
    pad_starts = pad_ends - padded
    dest = pad_starts[e_sorted] + jnp.arange(nk) - starts[e_sorted]
    n_blocks = -(-nk // MOE_BLOCK) + N_EXPERTS
    p = n_blocks * MOE_BLOCK
    tok_buf = jnp.zeros((p,), jnp.int32).at[dest].set(tok_flat[order])
    w_buf = jnp.zeros((p,), f32).at[dest].set(w_flat[order])
    x_buf = xt[tok_buf].reshape(n_blocks, MOE_BLOCK, d)
    blk_e = jnp.searchsorted(pad_ends, jnp.arange(n_blocks) * MOE_BLOCK, side='right')
    blk_e = jnp.minimum(blk_e, N_EXPERTS - 1)

    def expert_block(args):
        xb, e = args
        return (jax.nn.silu(xb @ w_gate[e]) * (xb @ w_up[e])) @ w_down[e]

    y_buf = lax.map(expert_block, (x_buf, blk_e)).reshape(p, d)
    y_buf = y_buf * w_buf[:, None].astype(y_buf.dtype)
    out = jax.ops.segment_sum(y_buf, tok_buf, num_segments=n)
    return out.reshape(b, s, d).astype(h.dtype)


def setup_inputs(seed: int = 0) -> dict:
    key = jax.random.key(seed)
    ks = iter(jax.random.split(key, 32))
    nrm = lambda shape, scale: jax.random.normal(next(ks), shape, jnp.float32) * scale
    gain = lambda shape: 1.0 + nrm(shape, 0.02)
    d = D_MODEL
    return {
        'x': nrm((BATCH, SEQ, d), 1.0),
        'norm_mix_g': gain((DEPTH, d)),
        'norm_ffn_g': gain((DEPTH, d)),
        'ab_w_in': nrm((N_EVEN, d, 3 * d), d ** -0.5),
        'a_q_gain': gain((N_EVEN, HEAD_DIM)),
        'a_k_gain': gain((N_EVEN, HEAD_DIM)),
        'a_lam_q1': nrm((N_EVEN, HEAD_DIM), 0.1),
        'a_lam_k1': nrm((N_EVEN, HEAD_DIM), 0.1),
        'a_lam_q2': nrm((N_EVEN, HEAD_DIM), 0.1),
        'a_lam_k2': nrm((N_EVEN, HEAD_DIM), 0.1),
        'a_subln_g': gain((N_EVEN, A_VDIM)),
        'ab_w_out': nrm((N_EVEN, d, d), d ** -0.5),
        'c_w_in': nrm((N_ODD, d, 3 * d + C_HEADS), d ** -0.5),
        'c_b_f': jax.random.uniform(next(ks), (N_ODD, C_HEADS), jnp.float32, 2.0, 5.0),
        'c_q_gain': gain((N_ODD, HEAD_DIM)),
        'c_k_gain': gain((N_ODD, HEAD_DIM)),
        'c_w_out': nrm((N_ODD, d, d), d ** -0.5),
        'moe_w_group': nrm((DEPTH, d, N_GROUPS), d ** -0.5),
        'moe_b_group': nrm((DEPTH, N_GROUPS), 0.01),
        'moe_w_router': nrm((DEPTH, d, N_EXPERTS), d ** -0.5),
        'moe_b_router': nrm((DEPTH, N_EXPERTS), 0.01),
        'moe_w_gate': nrm((DEPTH, N_EXPERTS, d, D_EXPERT), d ** -0.5),
        'moe_w_up': nrm((DEPTH, N_EXPERTS, d, D_EXPERT), d ** -0.5),
        'moe_w_down': nrm((DEPTH, N_EXPERTS, D_EXPERT, d), D_EXPERT ** -0.5),
    }


def reference(x, norm_mix_g, norm_ffn_g, ab_w_in, a_q_gain, a_k_gain, a_lam_q1, a_lam_k1,
              a_lam_q2, a_lam_k2, a_subln_g, ab_w_out, c_w_in, c_b_f, c_q_gain, c_k_gain,
              c_w_out, moe_w_group, moe_b_group, moe_w_router, moe_b_router, moe_w_gate,
              moe_w_up, moe_w_down):
    for layer in range(DEPTH):
        i = layer // 2
        h = rms_norm(x, norm_mix_g[layer])
        if layer % 2 == 0:
            mix = even_mixer(h, ab_w_in[i], a_q_gain[i], a_k_gain[i], a_lam_q1[i], a_lam_k1[i],
                             a_lam_q2[i], a_lam_k2[i], a_subln_g[i], ab_w_out[i], layer)
        else:
            mix = odd_mixer(h, c_w_in[i], c_b_f[i], c_q_gain[i], c_k_gain[i], c_w_out[i])
        x = x + mix
        h = rms_norm(x, norm_ffn_g[layer])
        x = x + hier_moe(h, moe_w_group[layer], moe_b_group[layer], moe_w_router[layer],
                         moe_b_router[layer], moe_w_gate[layer], moe_w_up[layer], moe_w_down[layer])
    return x
```

```cpp
#include <hip/hip_runtime.h>
#include <hip/hip_bf16.h>
#include <cstdio>
#include <cstdint>
#include <cmath>

#define GAS __attribute__((address_space(1)))
#define LAS __attribute__((address_space(3)))
typedef unsigned short bf16_t;
typedef short bf16x8 __attribute__((ext_vector_type(8)));
typedef short s16x4 __attribute__((ext_vector_type(4)));
typedef float f32x2 __attribute__((ext_vector_type(2)));
typedef float f32x4 __attribute__((ext_vector_type(4)));
typedef float f32x16 __attribute__((ext_vector_type(16)));
typedef unsigned u32x2 __attribute__((ext_vector_type(2)));
typedef unsigned u32x4 __attribute__((ext_vector_type(4)));

constexpr int BATCH = 2, SEQ = 8192, DM = 1024, M = BATCH * SEQ, DEPTH = 4;
constexpr int NQKV = 3072, PQ = 3072;
constexpr int NEXP = 16, LISTCAP = 16384, PMAX = 36864;
constexpr float EPS = 1e-6f;
constexpr float LOG2E = 1.4426950408889634f, C2 = 0.125f * LOG2E;
constexpr int NWAVES = 8;

constexpr size_t MiB = 1u << 20;
constexpr size_t WS_CTL = 0, CTL_ZERO_BYTES = 1 * MiB;
constexpr size_t WS_FTAB = 2 * MiB;
constexpr size_t WS_LOGF = 3 * MiB;
constexpr size_t WS_ROUTE = 4 * MiB;
constexpr size_t WS_LISTS = 5 * MiB;
constexpr size_t WS_WIN = 8 * MiB;
constexpr size_t WS_WOUT = 32 * MiB;
constexpr size_t WS_WGU = 40 * MiB;
constexpr size_t WS_WD = 296 * MiB;
constexpr size_t WS_XN = 424 * MiB;
constexpr size_t WS_QKV = 456 * MiB;
constexpr size_t WS_O = 552 * MiB;
constexpr size_t WS_AO = 584 * MiB;
constexpr size_t WS_H = 616 * MiB;
constexpr size_t WS_Y = 688 * MiB;
constexpr size_t WS_END = 760 * MiB;
constexpr int CW_BAR = 4096;
constexpr int CW_CNT = 1024;

constexpr int RING_BYTES = 131072;
constexpr int LDSCTL_OFF = RING_BYTES, MISC_OFF = LDSCTL_OFF + 320;
constexpr int GTAB_OFF = LDSCTL_OFF + 1024;
constexpr int MOETAB_OFF = LDSCTL_OFF + 2048;
constexpr int LDS_BYTES = 147456;

#define RLX_AGENT __ATOMIC_RELAXED, __HIP_MEMORY_SCOPE_AGENT
#define LDS_WAIT() asm volatile("s_waitcnt lgkmcnt(0)" ::: "memory")
#define VM_WAIT() asm volatile("s_waitcnt vmcnt(0)" ::: "memory")
__device__ __forceinline__ unsigned cvt_pk_bf16(float lo, float hi) { unsigned r; asm volatile("v_cvt_pk_bf16_f32 %0, %1, %2" : "=v"(r) : "v"(lo), "v"(hi)); return r; }
__device__ __forceinline__ float bf_lo(unsigned u) { return __uint_as_float(u << 16); }
__device__ __forceinline__ float bf_hi(unsigned u) { return __uint_as_float(u & 0xffff0000u); }
template <int MSK> __device__ __forceinline__ float xor_swz(float v) { return __int_as_float(__builtin_amdgcn_ds_swizzle(__float_as_int(v), (MSK << 10) | 0x1F)); }
__device__ __forceinline__ float xor32_partner(float v, bool upper) { auto rr = __builtin_amdgcn_permlane32_swap(__float_as_uint(v), __float_as_uint(v), false, false); return __uint_as_float(upper ? rr[0] : rr[1]); }
__device__ __forceinline__ float xor32_sum(float v) { auto rr = __builtin_amdgcn_permlane32_swap(__float_as_uint(v), __float_as_uint(v), false, false); return __uint_as_float(rr[0]) + __uint_as_float(rr[1]); }
__device__ __forceinline__ float wave_sum(float v) {
    v += xor_swz<1>(v); v += xor_swz<2>(v); v += xor_swz<4>(v); v += xor_swz<8>(v); v += xor_swz<16>(v); return xor32_sum(v);
}
__device__ __forceinline__ float wave_max(float v) {
    v = fmaxf(v, xor_swz<1>(v)); v = fmaxf(v, xor_swz<2>(v)); v = fmaxf(v, xor_swz<4>(v)); v = fmaxf(v, xor_swz<8>(v)); v = fmaxf(v, xor_swz<16>(v));
    auto rr = __builtin_amdgcn_permlane32_swap(__float_as_uint(v), __float_as_uint(v), false, false); return fmaxf(__uint_as_float(rr[0]), __uint_as_float(rr[1]));
}

namespace pg8 {
constexpr int BM = 256, BK = 64, HALF = 128, HTB = HALF * BK * 2, STAGE_BYTES = 8 * HTB, NXCD = 8, WGM = 8, K = 1024;
__host__ __device__ __forceinline__ int lds_byte(int r, int c) { const int st = (r >> 4) * 2 + (c >> 5), rr = r & 15, cc = c & 31, ob = rr * 64 + cc * 2; return st * 1024 + (ob ^ (((ob >> 9) & 1) << 5)); }
__host__ __device__ __forceinline__ void stage_rc(int b, int& R, int& C) { const int st = b / 1024, sb = b % 1024, swz = sb ^ (((sb >> 9) & 1) << 5); R = (st >> 1) * 16 + swz / 64; C = (st & 1) * 32 + (swz % 64) / 2; }
__host__ __device__ __forceinline__ int perm32(int rho) { const int n = rho >> 4, i = rho & 15; return 8 * (i >> 2) + 4 * n + (i & 3); }

struct Unit {
    const char* a;
    const char* b;
    const int* list;
    int nvalid;
    int row0, col0;
    int mode;
};

struct StaticOrder {
    int nM, nN, nwg, G, c;
    __device__ void init(int M_, int N_, int G_, int c_) { nM = M_ / BM; nN = N_ / BM; nwg = nM * nN; G = G_; c = c_; }
    __device__ bool next(int i, int& pm, int& pn) const {
        const long L = (long)i * G + c; if (L >= nwg) return false;
        int wgid = (int)L; { const int q = nwg / NXCD, r = nwg % NXCD, xcd = wgid % NXCD, off = wgid / NXCD; wgid = (xcd < r ? xcd * (q + 1) : r * (q + 1) + (xcd - r) * q) + off; }
        const int nig = WGM * nN, gid = wgid / nig, fm = gid * WGM, gsz = (nM - fm) < WGM ? (nM - fm) : WGM;
        pm = fm + ((wgid % nig) % gsz); pn = (wgid % nig) / gsz; return true;
    }
};

typedef f32x4 Acc[2][2][4][2];

template <class Epi, class Sched, bool GATHER>
__device__ __forceinline__ void gemm_phase(LAS unsigned char* lds, const Sched& S, const Epi& E, const int tid) {
    const int wid = __builtin_amdgcn_readfirstlane(tid >> 6), lane = tid & 63, wr = wid >> 2, wc = wid & 3, fr = lane & 15, fq = lane >> 4;
    constexpr int nt = K / BK;
    unsigned voffB[2], vA[2][2], vN[2][2];
#pragma unroll
    for (int i = 0; i < 2; ++i) { int R, C; stage_rc(tid * 16 + i * 8192, R, C); const int Rb = Epi::PERM ? ((R & ~31) + perm32(R & 31)) : R;
        voffB[i] = (unsigned)(Rb * K + C) * 2u;
        vA[0][i] = (unsigned)(R * K + C) * 2u; vA[1][i] = vA[0][i]; vN[0][i] = vA[0][i]; vN[1][i] = vA[0][i]; }
    constexpr size_t hA = GATHER ? (size_t)0 : (size_t)HALF * K * 2;
    constexpr size_t kstep = (size_t)(BK * 2);
    constexpr size_t hstep = (size_t)HALF * K * 2;
    const unsigned ldsw = (unsigned)wid * 1024u;
    const int aoff = lds_byte(wr * 64 + fr, fq * 8), boff = lds_byte(wc * 32 + fr, fq * 8);
#define PG8_SA(b, h) (((b) * 2 + (h)) * HTB)
#define PG8_SB(b, h) ((4 + (b) * 2 + (h)) * HTB)
#define PG8_STAGE(bufoff, gbase, voff) do { _Pragma("unroll") for (int _i = 0; _i < 2; ++_i) \
        __builtin_amdgcn_global_load_lds((const unsigned*)((const char*)(gbase) + (voff)[_i]), (LAS unsigned*)(lds + (bufoff) + ldsw + _i * 8192), 16, 0, 0); } while (0)
#define PG8_LDA(dst, b, h) do { _Pragma("unroll") for (int m = 0; m < 4; ++m) _Pragma("unroll") for (int k = 0; k < 2; ++k) dst[m][k] = *(const LAS bf16x8*)(lds + PG8_SA(b, h) + aoff + m * 2048 + k * 1024); } while (0)
#define PG8_LDB(dst, b, h) do { _Pragma("unroll") for (int n = 0; n < 2; ++n) _Pragma("unroll") for (int k = 0; k < 2; ++k) dst[n][k] = *(const LAS bf16x8*)(lds + PG8_SB(b, h) + boff + n * 2048 + k * 1024); } while (0)
#define PG8_MMA(ai, bj, At, Bt) do { __builtin_amdgcn_s_setprio(1); _Pragma("unroll") for (int m = 0; m < 4; ++m) _Pragma("unroll") for (int n = 0; n < 2; ++n) _Pragma("unroll") for (int k = 0; k < 2; ++k) \
        acc[ai][bj][m][n] = __builtin_amdgcn_mfma_f32_16x16x32_bf16(Bt[n][k], At[m][k], acc[ai][bj][m][n], 0, 0, 0); __builtin_amdgcn_s_setprio(0); } while (0)
#define PG8_WAIT_V(n) asm volatile("s_waitcnt vmcnt(" #n ")" ::: "memory")
#define PG8_WAIT_L(n) asm volatile("s_waitcnt lgkmcnt(" #n ")" ::: "memory")
#define PG8_BAR __builtin_amdgcn_s_barrier()
#define PG8_SCHED __builtin_amdgcn_sched_barrier(0)
#define PG8_GVOFF(u, vo) do { _Pragma("unroll") for (int _h = 0; _h < 2; ++_h) _Pragma("unroll") for (int _i = 0; _i < 2; ++_i) { int _R, _C; stage_rc(tid * 16 + _i * 8192, _R, _C); \
        const int _idx = _h * HALF + _R; const int _tok = (_idx < (u).nvalid) ? (u).list[_idx] : 0; vo[_h][_i] = (unsigned)(_tok * K + _C) * 2u; } } while (0)
    Unit cur, nxt; int ui = 0;
    if (!S.next(0, cur)) return;
    if constexpr (GATHER) { PG8_GVOFF(cur, vA); }
    Acc acc;
#pragma unroll
    for (int a = 0; a < 2; ++a)
#pragma unroll
        for (int b = 0; b < 2; ++b)
#pragma unroll
            for (int m = 0; m < 4; ++m)
#pragma unroll
                for (int n = 0; n < 2; ++n) acc[a][b][m][n] = (f32x4){0.f, 0.f, 0.f, 0.f};
    bf16x8 At[4][2], B0[2][2], B1[2][2];
    const char* cA = cur.a; const char* cB = cur.b;
    PG8_STAGE(PG8_SB(0, 0), cB, voffB); PG8_STAGE(PG8_SB(0, 1), cB + hstep, voffB); PG8_STAGE(PG8_SA(0, 0), cA, vA[0]); PG8_STAGE(PG8_SA(0, 1), cA + hA, vA[GATHER ? 1 : 0]);
    if (wr == 1) PG8_BAR;
    PG8_WAIT_V(2); PG8_BAR;
    PG8_STAGE(PG8_SB(1, 0), cB + kstep, voffB); PG8_STAGE(PG8_SA(1, 0), cA + kstep, vA[0]); PG8_STAGE(PG8_SB(1, 1), cB + hstep + kstep, voffB);
    PG8_WAIT_V(6); PG8_BAR;
    for (;;) {
        const bool has_next = S.next(ui + 1, nxt);
        if constexpr (GATHER) { if (has_next) { PG8_GVOFF(nxt, vN); } }
        const char* nA = has_next ? nxt.a : cA; const char* nB = has_next ? nxt.b : cB;
        for (int t = 0; t < nt; t += 2) {
            const bool last = (t == nt - 2);
            const char* a1 = cA + (size_t)(t + 1) * kstep;
            const char* a2 = last ? nA : cA + (size_t)(t + 2) * kstep; const char* b2 = last ? nB : cB + (size_t)(t + 2) * kstep;
            const char* a3 = a2 + kstep; const char* b3 = b2 + kstep;
            unsigned v2[2][2];
#pragma unroll
            for (int h = 0; h < 2; ++h)
#pragma unroll
                for (int i = 0; i < 2; ++i) v2[h][i] = (GATHER && last) ? vN[h][i] : vA[GATHER ? h : 0][i];
            PG8_LDB(B0, 0, 0); PG8_LDB(B1, 0, 1); PG8_SCHED; PG8_LDA(At, 0, 0); PG8_STAGE(PG8_SA(1, 1), a1 + hA, vA[GATHER ? 1 : 0]);
            PG8_WAIT_V(8); PG8_WAIT_L(0); PG8_BAR; PG8_MMA(0, 0, At, B0); PG8_MMA(0, 1, At, B1); PG8_BAR; PG8_SCHED;
            PG8_LDA(At, 0, 1); PG8_STAGE(PG8_SB(0, 0), b2, voffB); PG8_STAGE(PG8_SB(0, 1), b2 + hstep, voffB); PG8_STAGE(PG8_SA(0, 0), a2, v2[0]);
            PG8_WAIT_V(8); PG8_WAIT_L(0); PG8_BAR; PG8_MMA(1, 0, At, B0); PG8_MMA(1, 1, At, B1); PG8_BAR; PG8_SCHED;
            PG8_LDB(B0, 1, 0); PG8_LDB(B1, 1, 1); PG8_SCHED; PG8_LDA(At, 1, 0); PG8_STAGE(PG8_SA(0, 1), a2 + hA, v2[1]);
            PG8_WAIT_V(8); PG8_WAIT_L(0); PG8_BAR; PG8_MMA(0, 0, At, B0); PG8_MMA(0, 1, At, B1); PG8_BAR; PG8_SCHED;
            PG8_LDA(At, 1, 1); PG8_STAGE(PG8_SB(1, 0), b3, voffB); PG8_STAGE(PG8_SB(1, 1), b3 + hstep, voffB); PG8_STAGE(PG8_SA(1, 0), a3, v2[0]);
            PG8_WAIT_V(8); PG8_WAIT_L(0); PG8_BAR; PG8_MMA(1, 0, At, B0); PG8_MMA(1, 1, At, B1); PG8_BAR; PG8_SCHED;
        }
        if (wr == 0) PG8_BAR;
        E(acc, cur, wr, wc, fr, fq);
        if (!has_next) break;
#pragma unroll
        for (int a = 0; a < 2; ++a)
#pragma unroll
            for (int b = 0; b < 2; ++b)
#pragma unroll
                for (int m = 0; m < 4; ++m)
#pragma unroll
                    for (int n = 0; n < 2; ++n) acc[a][b][m][n] = (f32x4){0.f, 0.f, 0.f, 0.f};
        cur = nxt; cA = nA; cB = nB; ++ui;
        if constexpr (GATHER) {
#pragma unroll
            for (int h = 0; h < 2; ++h)
#pragma unroll
                for (int i = 0; i < 2; ++i) vA[h][i] = vN[h][i];
        }
        if (wr == 1) PG8_BAR;
    }
    PG8_WAIT_V(0);
    PG8_BAR;
#undef PG8_SA
#undef PG8_SB
#undef PG8_STAGE
#undef PG8_LDA
#undef PG8_LDB
#undef PG8_MMA
#undef PG8_WAIT_V
#undef PG8_WAIT_L
#undef PG8_BAR
#undef PG8_SCHED
#undef PG8_GVOFF
}

struct EpiProj {
    static constexpr bool PERM = true;
    bf16_t* O; const LAS float* gtab;
    __device__ __forceinline__ void operator()(const Acc& acc, const Unit& u, int wr, int wc, int fr, int fq) const {
        const int mode = u.mode;
        f32x4 g[2][2];
#pragma unroll
        for (int bj = 0; bj < 2; ++bj)
#pragma unroll
            for (int n = 0; n < 2; ++n) g[bj][n] = (mode == 1 || mode == 2) ? *(const LAS f32x4*)(gtab + (mode - 1) * 64 + 32 * bj + 8 * fq + 4 * n) : (f32x4){1.f, 1.f, 1.f, 1.f};
        const float sc = (mode == 3) ? C2 : 1.f;
#pragma unroll
        for (int ai = 0; ai < 2; ++ai)
#pragma unroll
            for (int m = 0; m < 4; ++m) {
                const int row = u.row0 + ai * HALF + wr * 64 + m * 16 + fr;
                float rs = sc;
                if (mode == 1 || mode == 2) {
                    float ss = 0.f;
#pragma unroll
                    for (int bj = 0; bj < 2; ++bj)
#pragma unroll
                        for (int n = 0; n < 2; ++n) { const f32x4 v = acc[ai][bj][m][n]; ss += (v[0] * v[0] + v[1] * v[1]) + (v[2] * v[2] + v[3] * v[3]); }
                    ss += xor_swz<16>(ss); ss = xor32_sum(ss);
                    rs = __builtin_amdgcn_rsqf(ss * (1.f / 64.f) + EPS);
                }
                bf16_t* rowp = O + (size_t)row * NQKV + u.col0 + 64 * wc + 8 * fq;
#pragma unroll
                for (int bj = 0; bj < 2; ++bj) {
                    const f32x4 v0 = acc[ai][bj][m][0] * rs * g[bj][0], v1 = acc[ai][bj][m][1] * rs * g[bj][1];
                    u32x4 w; w.x = cvt_pk_bf16(v0[0], v0[1]); w.y = cvt_pk_bf16(v0[2], v0[3]); w.z = cvt_pk_bf16(v1[0], v1[1]); w.w = cvt_pk_bf16(v1[2], v1[3]);
                    *(u32x4*)(rowp + 32 * bj) = w;
                }
            }
    }
};
struct EpiResid {
    static constexpr bool PERM = false;
    float* X;
    __device__ __forceinline__ void operator()(const Acc& acc, const Unit& u, int wr, int wc, int fr, int fq) const {
#pragma unroll
        for (int ai = 0; ai < 2; ++ai)
#pragma unroll
            for (int m = 0; m < 4; ++m) {
                float* rowp = X + (size_t)(u.row0 + ai * HALF + wr * 64 + m * 16 + fr) * DM + u.col0 + wc * 32 + 4 * fq;
#pragma unroll
                for (int bj = 0; bj < 2; ++bj)
#pragma unroll
                    for (int n = 0; n < 2; ++n) { f32x4* p = (f32x4*)(rowp + bj * HALF + n * 16); *p = *p + acc[ai][bj][m][n]; }
                if (m & 1) asm volatile("" ::: "memory");
            }
    }
};
struct EpiSwiGLU {
    static constexpr bool PERM = true;
    bf16_t* Hb;
    __device__ __forceinline__ void operator()(const Acc& acc, const Unit& u, int wr, int wc, int fr, int fq) const {
#pragma unroll
        for (int ai = 0; ai < 2; ++ai)
#pragma unroll
            for (int m = 0; m < 4; ++m) {
                bf16_t* rowp = Hb + (size_t)(u.row0 + ai * HALF + wr * 64 + m * 16 + fr) * DM + u.col0 + wc * 32 + 8 * fq;
                float r[8];
#pragma unroll
                for (int n = 0; n < 2; ++n)
#pragma unroll
                    for (int i = 0; i < 4; ++i) { const float gt = acc[ai][0][m][n][i], up = acc[ai][1][m][n][i];
                        r[4 * n + i] = gt * __builtin_amdgcn_rcpf(1.f + __builtin_amdgcn_exp2f(-gt * LOG2E)) * up; }
                u32x4 w; w.x = cvt_pk_bf16(r[0], r[1]); w.y = cvt_pk_bf16(r[2], r[3]); w.z = cvt_pk_bf16(r[4], r[5]); w.w = cvt_pk_bf16(r[6], r[7]);
                *(u32x4*)rowp = w;
            }
    }
};
struct EpiBf16 {
    static constexpr bool PERM = true;
    bf16_t* Yb;
    __device__ __forceinline__ void operator()(const Acc& acc, const Unit& u, int wr, int wc, int fr, int fq) const {
#pragma unroll
        for (int ai = 0; ai < 2; ++ai)
#pragma unroll
            for (int m = 0; m < 4; ++m) {
                bf16_t* rowp = Yb + (size_t)(u.row0 + ai * HALF + wr * 64 + m * 16 + fr) * DM + u.col0 + wc * 32 + 8 * fq;
#pragma unroll
                for (int bj = 0; bj < 2; ++bj) { const f32x4 v0 = acc[ai][bj][m][0], v1 = acc[ai][bj][m][1];
                    u32x4 w; w.x = cvt_pk_bf16(v0[0], v0[1]); w.y = cvt_pk_bf16(v0[2], v0[3]); w.z = cvt_pk_bf16(v1[0], v1[1]); w.w = cvt_pk_bf16(v1[2], v1[3]);
                    *(u32x4*)(rowp + bj * HALF) = w; }
            }
    }
};

struct ProjSched {
    StaticOrder so; const char* A; const char* W; int mq, mk, s_lo, s_hi;
    __device__ bool next(int i, Unit& u) const { int pm, pn; if (!so.next(i, pm, pn)) return false;
        u.a = A + (size_t)pm * BM * K * 2; u.b = W + (size_t)pn * BM * K * 2; u.list = nullptr; u.nvalid = 0; u.row0 = pm * BM; u.col0 = pn * BM;
        u.mode = pn < mq ? 1 : (pn < mk ? 2 : ((pn >= s_lo && pn < s_hi) ? 3 : 0)); return true; }
};
struct WoutSched {
    StaticOrder so; const char* A; const char* W;
    __device__ bool next(int i, Unit& u) const { int pm, pn; if (!so.next(i, pm, pn)) return false;
        u.a = A + (size_t)pm * BM * K * 2; u.b = W + (size_t)pn * BM * K * 2; u.list = nullptr; u.nvalid = 0; u.row0 = pm * BM; u.col0 = pn * BM; u.mode = 0; return true; }
};
template <int NT, bool UP> struct MoeSched {
    const LAS int* tab;
    int G, c; const char* A; const char* W; const int* lists;
    __device__ bool next(int i, Unit& u) const {
        const int total = tab[16];
        const long L = (long)i * G + c; if (L >= (long)total * NT) return false;
        const int rt = (int)(L / NT), pn = (int)(L % NT);
        int e = 0;
#pragma unroll
        for (int j = 1; j < 16; ++j) e += (rt >= tab[j]) ? 1 : 0;
        e = __builtin_amdgcn_readfirstlane(e);
        const int r0 = __builtin_amdgcn_readfirstlane(tab[e]), ce = __builtin_amdgcn_readfirstlane(tab[17 + e]);
        const int rel0 = (rt - r0) * BM;
        if (UP) { u.a = A; u.b = W + ((size_t)e * 2048 + (size_t)pn * BM) * K * 2; u.list = lists + e * LISTCAP + rel0; u.nvalid = ce - rel0; u.col0 = pn * 128; }
        else    { u.a = A + (size_t)rt * BM * K * 2; u.b = W + ((size_t)e * 1024 + (size_t)pn * BM) * K * 2; u.list = nullptr; u.nvalid = 0; u.col0 = pn * BM; }
        u.row0 = rt * BM; u.mode = 0; return true;
    }
};
}

namespace att {
using bf16 = __hip_bfloat16;
constexpr int NW = 8, QBLK = 32, QB = QBLK * NW, KVBLK = 64;
constexpr int NSLOT = 3, SLOTB = 8192;
constexpr int LDS_K = 0, LDS_V = NSLOT * SLOTB, LDS_WS = 2 * NSLOT * SLOTB, LDS_OST = LDS_WS + NW * 64 * 4, LDS_END = LDS_OST + NW * 4096;
constexpr int LDS_FTAB = 86016;
static_assert(LDS_END <= LDS_FTAB && LDS_FTAB + 32768 <= RING_BYTES, "attention LDS map");
__device__ __forceinline__ int crow(int r, int hi) { return (r & 3) + 8 * (r >> 2) + 4 * hi; }
#define SBAR() __builtin_amdgcn_sched_barrier(0)
__device__ __forceinline__ void glds16(const void* gsrc, unsigned lds_dst) { unsigned keep;
  asm volatile("s_mov_b32 %0, m0\n\ts_mov_b32 m0, %2\n\ts_nop 0\n\tglobal_load_lds_dwordx4 %1, off\n\ts_mov_b32 m0, %0" : "=&s"(keep) : "v"(gsrc), "s"(lds_dst) : "memory"); }
typedef __bf16 bf16x2_t __attribute__((ext_vector_type(2)));
__device__ __forceinline__ unsigned cvtpk_s(float lo, float hi) { f32x2 v = {lo, hi}; bf16x2_t b = __builtin_convertvector(v, bf16x2_t); return __builtin_bit_cast(unsigned, b); }
#define WAIT_BAR(N) asm volatile("s_waitcnt vmcnt(" #N ") lgkmcnt(0)\n\ts_barrier" ::: "memory")
typedef LAS const char* lds_cptr;
typedef short v4i16_t __attribute__((ext_vector_type(4)));

__device__ __forceinline__ void qkt_acc(f32x16& p0, f32x16& p1, const char* Kslot, const bf16x8* qr, int r32, int hi) {
  const char* kb = Kslot + hi * 1024 + r32 * 16;
#pragma unroll
  for (int d0 = 0; d0 < 4; ++d0) {
    const bf16x8 b0 = *reinterpret_cast<const bf16x8*>(kb + d0 * 2048);
    const bf16x8 b1 = *reinterpret_cast<const bf16x8*>(kb + d0 * 2048 + 512);
    p0 = __builtin_amdgcn_mfma_f32_32x32x16_bf16(b0, qr[d0], p0, 0, 0, 0); p1 = __builtin_amdgcn_mfma_f32_32x32x16_bf16(b1, qr[d0], p1, 0, 0, 0); }
}
__device__ __forceinline__ void kload8(bf16x8* kf, lds_cptr kp) {
  kf[0] = *(const LAS bf16x8*)(kp);        kf[1] = *(const LAS bf16x8*)(kp + 512);
  kf[2] = *(const LAS bf16x8*)(kp + 2048); kf[3] = *(const LAS bf16x8*)(kp + 2560);
  kf[4] = *(const LAS bf16x8*)(kp + 4096); kf[5] = *(const LAS bf16x8*)(kp + 4608);
  kf[6] = *(const LAS bf16x8*)(kp + 6144); kf[7] = *(const LAS bf16x8*)(kp + 6656);
}
__device__ __forceinline__ void kload2(bf16x8* kf, lds_cptr kp, int j) { kf[2 * j] = *(const LAS bf16x8*)(kp + j * 2048); kf[2 * j + 1] = *(const LAS bf16x8*)(kp + j * 2048 + 512); }
__device__ __forceinline__ s16x4 vtr(lds_cptr p) { return __builtin_bit_cast(s16x4, __builtin_amdgcn_ds_read_tr16_b64_v4i16((LAS v4i16_t*)p)); }
__device__ __forceinline__ void pv(f32x16* o, int vb, bf16x8 pa0, bf16x8 pa1, bf16x8 pa2, bf16x8 pa3) {
#pragma unroll
  for (int d0 = 0; d0 < 2; ++d0) { s16x4 lo[4], hi[4];
#pragma unroll
    for (int ks = 0; ks < 4; ++ks) {
      asm volatile("ds_read_b64_tr_b16 %0,%1 offset:%c2" : "=&v"(lo[ks]) : "v"(vb), "i"(d0 * 4096 + ks * 1024) : "memory");
      asm volatile("ds_read_b64_tr_b16 %0,%1 offset:%c2" : "=&v"(hi[ks]) : "v"(vb), "i"(d0 * 4096 + ks * 1024 + 512) : "memory"); }
    asm volatile("s_waitcnt lgkmcnt(0)" ::: "memory"); SBAR();
#define PK(k) (bf16x8){lo[k][0], lo[k][1], lo[k][2], lo[k][3], hi[k][0], hi[k][1], hi[k][2], hi[k][3]}
    o[d0] = __builtin_amdgcn_mfma_f32_32x32x16_bf16(pa0, PK(0), o[d0], 0, 0, 0);
    o[d0] = __builtin_amdgcn_mfma_f32_32x32x16_bf16(pa1, PK(1), o[d0], 0, 0, 0);
    o[d0] = __builtin_amdgcn_mfma_f32_32x32x16_bf16(pa2, PK(2), o[d0], 0, 0, 0);
    o[d0] = __builtin_amdgcn_mfma_f32_32x32x16_bf16(pa3, PK(3), o[d0], 0, 0, 0);
#undef PK
  }
}
template <int PO> __device__ __forceinline__ void store_o(const f32x16* o, const float* rs, bf16* Ow, char* shm, int wid, int lane, int r32, int hi) {
  bf16* stg = (bf16*)(shm + LDS_OST) + wid * 2048;
#pragma unroll
  for (int r = 0; r < 16; ++r) { const int orow = crow(r, hi);
#pragma unroll
    for (int d0 = 0; d0 < 2; ++d0) stg[orow * 64 + d0 * 32 + r32] = __float2bfloat16(o[d0][r] * rs[r]); }
  asm volatile("s_waitcnt lgkmcnt(0)" ::: "memory");
#pragma unroll
  for (int i = 0; i < 4; ++i) { const int row = i * 8 + (lane >> 3), ch = lane & 7; const u32x4 v = *(const u32x4*)(stg + row * 64 + ch * 8); *(u32x4*)(Ow + (long)row * PO + ch * 8) = v; }
}

template <int PO> __device__ __forceinline__ void attn_unit_b(int qb, const bf16* Qh, const bf16* __restrict__ Kh, const bf16* __restrict__ Vh, bf16* Oh, float Bp, char* shm, const int tid) {
  const int lane = tid & 63, r32 = lane & 31, hi = lane >> 5; const int wid = __builtin_amdgcn_readfirstlane(tid >> 6);
  const int q0 = qb * QB;
  const bf16* Qw = Qh + (long)(q0 + wid * QBLK) * PQ;
  const unsigned lds0 = (unsigned)(uintptr_t)shm;
  float* wsf = (float*)(shm + LDS_WS) + wid * 64;
  const bf16* ksrc = Kh + (long)lane * PQ + wid * 8;
  const bf16* vsrc = Vh + (long)(16 * (wid & 3) + (lane >> 2)) * PQ + (wid >> 2) * 32 + (lane & 3) * 8;
  const unsigned kdst = lds0 + LDS_K + wid * 1024, vdst = lds0 + LDS_V + wid * 1024;
#define DMA_K(t, slot) glds16(ksrc + (long)(t) * KVBLK * PQ, (unsigned)__builtin_amdgcn_readfirstlane(kdst + (slot)))
#define DMA_V(t, slot) glds16(vsrc + (long)(t) * KVBLK * PQ, (unsigned)__builtin_amdgcn_readfirstlane(vdst + (slot)))
  const int vb0 = (int)(lds0 + LDS_V) + ((lane >> 4) & 1) * 32 + (lane & 3) * 8 + (4 * hi + ((lane & 15) >> 2)) * 64;
  const char* Kbase = shm + LDS_K; bf16x8 kf[8];
  const lds_cptr shm3 = (lds_cptr)shm; const lds_cptr kp0 = shm3 + LDS_K + hi * 1024 + r32 * 16; const lds_cptr vp0 = shm3 + LDS_V + ((lane >> 4) & 1) * 32 + (lane & 3) * 8 + (4 * hi + ((lane & 15) >> 2)) * 64;
  const LAS float* ftab = (const LAS float*)(shm3 + LDS_FTAB);
  const int NT = (q0 + QB) / KVBLK;
  DMA_K(0, 0); DMA_V(0, 0); DMA_K(1, SLOTB);
  bf16x8 qr[4];
#pragma unroll
  for (int d0 = 0; d0 < 4; ++d0) qr[d0] = *reinterpret_cast<const bf16x8*>(&Qw[(long)r32 * PQ + d0 * 16 + hi * 8]);
  float l_reg = 0.f; f32x16 o[2]; o[0] = f32x16{}; o[1] = f32x16{};
  const int qrel = wid * QBLK + r32;
  const float rc = ftab[q0 + qrel] - Bp;
  const LAS float* fth = ftab + 4 * hi;
#define CMASK(P0, P1, t) do { const int jb_ = (t) - (NT - 4); if (jb_ >= 0) { const int kb_ = 64 * jb_ + 4 * hi; \
    _Pragma("unroll") for (int r = 0; r < 16; ++r) { const int kv_ = kb_ + (r & 3) + 8 * (r >> 2); if (kv_ > qrel) P0[r] = -INFINITY; if (kv_ + 32 > qrel) P1[r] = -INFINITY; } } } while (0)
#define BIASG(P, t, ph, g) do { const f32x4 f_ = *(const LAS f32x4*)(fth + 64 * (t) + 32 * (ph) + 8 * (g)); \
    P[4 * (g)] = rc - f_[0]; P[4 * (g) + 1] = rc - f_[1]; P[4 * (g) + 2] = rc - f_[2]; P[4 * (g) + 3] = rc - f_[3]; } while (0)
#define BIAS_FULL(P0, P1, t) do { BIASG(P0, t, 0, 0); BIASG(P0, t, 0, 1); BIASG(P0, t, 0, 2); BIASG(P0, t, 0, 3); BIASG(P1, t, 1, 0); BIASG(P1, t, 1, 1); BIASG(P1, t, 1, 2); BIASG(P1, t, 1, 3); } while (0)
  f32x16 rcv;
#pragma unroll
  for (int r = 0; r < 16; ++r) rcv[r] = rc;
  asm volatile("" : "+v"(rcv));
  f32x16 pA0, pA1, pB0, pB1;
  BIAS_FULL(pA0, pA1, 0);
  int sl_prev = 0, sl_cur = 0, sl_next = SLOTB;
#define ROT() do { sl_prev = sl_cur; sl_cur = sl_next; sl_next = (sl_next == (NSLOT - 1) * SLOTB) ? 0 : sl_next + SLOTB; } while (0)
  DMA_K(2, 2 * SLOTB);
  WAIT_BAR(3);
  qkt_acc(pA0, pA1, Kbase, qr, r32, hi); CMASK(pA0, pA1, 0);
#pragma unroll
  for (int r = 0; r < 16; ++r) { pA0[r] = __builtin_amdgcn_exp2f(pA0[r]); pA1[r] = __builtin_amdgcn_exp2f(pA1[r]); }
  WAIT_BAR(0);
  DMA_K(3, 0); DMA_V(1, SLOTB);
  ROT();
  kload8(kf, kp0 + sl_cur);
  WAIT_BAR(2);
  s16x4 vlo[8], vhi[8]; u32x4 pw0, pw1, pw2, pw3;
#define PKW(P, B) cvtpk_s(P[B], P[B + 1])
#define PAF(k) __builtin_bit_cast(bf16x8, pw##k)
#define VFR(i) (bf16x8){vlo[i][0], vlo[i][1], vlo[i][2], vlo[i][3], vhi[i][0], vhi[i][1], vhi[i][2], vhi[i][3]}
#define PIN(x) asm volatile("" : "+v"(x))
#define GAPA(MF, A0, A1, A2, A3, W0, W1, PW) do { MF; sacc += A0; sacc += A1; sacc += A2; sacc += A3; PIN(sacc); W0; W1; PIN(PW); SBAR(); } while (0)
#define EX(v) __builtin_amdgcn_exp2f(v)
#define GAPB(MF, X, B) do { MF; X[B] = EX(X[B]); X[B + 1] = EX(X[B + 1]); X[B + 2] = EX(X[B + 2]); X[B + 3] = EX(X[B + 3]); PIN(X); SBAR(); } while (0)
#define FLD(P, t, ph, g) do { const f32x4 f_ = *(const LAS f32x4*)(fth + 64 * (t) + 32 * (ph) + 8 * (g)); P[4 * (g)] = f_[0]; P[4 * (g) + 1] = f_[1]; P[4 * (g) + 2] = f_[2]; P[4 * (g) + 3] = f_[3]; } while (0)
#define VRD(i) do { vlo[i] = vtr(vp_ + (((i) >> 2) * 4096 + ((i) & 3) * 1024)); vhi[i] = vtr(vp_ + (((i) >> 2) * 4096 + ((i) & 3) * 1024 + 512)); } while (0)
#define KRD(G, j) do { if (G) { kload2(kf, kp0 + sl_next, j); SBAR(); } } while (0)
#define MF32(a, b, c) __builtin_amdgcn_mfma_f32_32x32x16_bf16(a, b, c, 0, 0, 0)
#define STEP(C0, C1, P0, P1, t, GK, GV, GL) do { SBAR(); \
    const lds_cptr vp_ = vp0 + sl_prev; \
    VRD(0); SBAR(); float sacc = (P0[0] + P0[1]); \
    GAPA(C0 = MF32(kf[0], qr[0], rcv), P0[2], P0[3], P0[4], P0[5],     pw0[0] = PKW(P0, 0), pw0[1] = PKW(P0, 2), pw0); \
    VRD(4); SBAR(); GAPA(C1 = MF32(kf[1], qr[0], rcv), P0[6], P0[7], P0[8], P0[9],     pw0[2] = PKW(P0, 4), pw0[3] = PKW(P0, 6), pw0); \
    VRD(1); SBAR(); GAPA(C0 = MF32(kf[2], qr[1], C0), P0[10], P0[11], P0[12], P0[13], pw1[0] = PKW(P0, 8), pw1[1] = PKW(P0, 10), pw1); \
    VRD(5); SBAR(); GAPA(C1 = MF32(kf[3], qr[1], C1), P0[14], P0[15], P1[0], P1[1],   pw1[2] = PKW(P0, 12), pw1[3] = PKW(P0, 14), pw1); \
    VRD(2); FLD(P0, t, 0, 0); SBAR(); GAPA(C0 = MF32(kf[4], qr[2], C0), P1[2], P1[3], P1[4], P1[5],     pw2[0] = PKW(P1, 0), pw2[1] = PKW(P1, 2), pw2); \
    VRD(6); FLD(P0, t, 0, 1); SBAR(); GAPA(C1 = MF32(kf[5], qr[2], C1), P1[6], P1[7], P1[8], P1[9],     pw2[2] = PKW(P1, 4), pw2[3] = PKW(P1, 6), pw2); \
    VRD(3); FLD(P0, t, 0, 2); SBAR(); GAPA(C0 = MF32(kf[6], qr[3], C0), P1[10], P1[11], P1[12], P1[13], pw3[0] = PKW(P1, 8), pw3[1] = PKW(P1, 10), pw3); \
    VRD(7); FLD(P0, t, 0, 3); SBAR(); GAPA(C1 = MF32(kf[7], qr[3], C1), P1[14], P1[15], 0.f, 0.f,       pw3[2] = PKW(P1, 12), pw3[3] = PKW(P1, 14), pw3); \
    l_reg += sacc; \
    if (GK) { DMA_K((t) + 3, sl_cur); } if (GV) { DMA_V((t) + 1, sl_next); } \
    FLD(P1, t, 1, 0); FLD(P1, t, 1, 1); FLD(P1, t, 1, 2); FLD(P1, t, 1, 3); \
    _Pragma("unroll") for (int r = 0; r < 16; ++r) C0[r] -= P0[r]; \
    _Pragma("unroll") for (int r = 0; r < 16; ++r) C1[r] -= P1[r]; \
    CMASK(C0, C1, t); \
    SBAR(); \
    GAPB(o[0] = MF32(PAF(0), VFR(0), o[0]), C0, 0); \
    GAPB(o[1] = MF32(PAF(0), VFR(4), o[1]), C0, 4); \
    KRD(GL, 0); GAPB(o[0] = MF32(PAF(1), VFR(1), o[0]), C0, 8); \
    KRD(GL, 1); GAPB(o[1] = MF32(PAF(1), VFR(5), o[1]), C0, 12); \
    KRD(GL, 2); GAPB(o[0] = MF32(PAF(2), VFR(2), o[0]), C1, 0); \
    KRD(GL, 3); GAPB(o[1] = MF32(PAF(2), VFR(6), o[1]), C1, 4); \
    GAPB(o[0] = MF32(PAF(3), VFR(3), o[0]), C1, 8); \
    GAPB(o[1] = MF32(PAF(3), VFR(7), o[1]), C1, 12); \
    } while (0)
  int t = 1;
#undef CMASK
#define CMASK(P0, P1, t) do { } while (0)
  for (; t + 5 < NT; t += 2) {
    STEP(pB0, pB1, pA0, pA1, t, true, true, true);     WAIT_BAR(2); ROT();
    STEP(pA0, pA1, pB0, pB1, t + 1, true, true, true); WAIT_BAR(2); ROT();
  }
#undef CMASK
#define CMASK(P0, P1, t) do { const int jb_ = (t) - (NT - 4); if (jb_ >= 0) { const int kb_ = 64 * jb_ + 4 * hi; \
    _Pragma("unroll") for (int r = 0; r < 16; ++r) { const int kv_ = kb_ + (r & 3) + 8 * (r >> 2); if (kv_ > qrel) P0[r] = -INFINITY; if (kv_ + 32 > qrel) P1[r] = -INFINITY; } } } while (0)
#define ENDW(tt) do { if ((tt) + 3 < NT) { WAIT_BAR(2); } else if ((tt) + 2 < NT) { WAIT_BAR(1); } else { WAIT_BAR(0); } } while (0)
  for (; t + 1 < NT; t += 2) {
    STEP(pB0, pB1, pA0, pA1, t, (t + 3 < NT), (t + 1 < NT), (t + 1 < NT));         ENDW(t);     ROT();
    STEP(pA0, pA1, pB0, pB1, t + 1, (t + 4 < NT), (t + 2 < NT), (t + 2 < NT));     ENDW(t + 1); ROT();
  }
  STEP(pB0, pB1, pA0, pA1, NT - 1, false, false, false);
  { float sacc = pB0[0] + pB0[1];
#pragma unroll
    for (int r = 2; r < 16; ++r) sacc += pB0[r];
#pragma unroll
    for (int r = 0; r < 16; ++r) sacc += pB1[r];
    l_reg += sacc;
    pw0 = (u32x4){PKW(pB0, 0), PKW(pB0, 2), PKW(pB0, 4), PKW(pB0, 6)}; pw1 = (u32x4){PKW(pB0, 8), PKW(pB0, 10), PKW(pB0, 12), PKW(pB0, 14)};
    pw2 = (u32x4){PKW(pB1, 0), PKW(pB1, 2), PKW(pB1, 4), PKW(pB1, 6)}; pw3 = (u32x4){PKW(pB1, 8), PKW(pB1, 10), PKW(pB1, 12), PKW(pB1, 14)};
    SBAR(); pv(o, vb0 + sl_cur, PAF(0), PAF(1), PAF(2), PAF(3)); }
#undef PKW
#undef PAF
#undef VFR
#undef PIN
#undef GAPA
#undef GAPB
#undef FLD
#undef EX
#undef VRD
#undef KRD
#undef STEP
#undef ENDW
#undef MF32
  { auto rr = __builtin_amdgcn_permlane32_swap(__float_as_uint(l_reg), __float_as_uint(l_reg), false, false); l_reg = __uint_as_float(rr[0]) + __uint_as_float(rr[1]); }
  if (hi == 0) wsf[32 + r32] = l_reg; asm volatile("s_waitcnt lgkmcnt(0)" ::: "memory");
  float rli[16];
#pragma unroll
  for (int r = 0; r < 16; ++r) rli[r] = __builtin_amdgcn_rcpf(wsf[32 + crow(r, hi)]);
  store_o<PO>(o, rli, Oh + (long)(q0 + wid * QBLK) * PO, shm, wid, lane, r32, hi);
  asm volatile("s_waitcnt lgkmcnt(0)\n\ts_barrier" ::: "memory");
#undef DMA_K
#undef DMA_V
#undef CMASK
#undef BIASG
#undef BIAS_FULL
#undef ROT
}

template <int PO> __device__ __forceinline__ void sb_unit(int qb, const bf16* Qh, const bf16* __restrict__ Kh, const bf16* __restrict__ Vh, bf16* Oh, char* shm, const int tid) {
  const int lane = tid & 63, r32 = lane & 31, hi = lane >> 5; const int wid = __builtin_amdgcn_readfirstlane(tid >> 6);
  const int q0 = qb * QB;
  const bf16* Qw = Qh + (long)(q0 + wid * QBLK) * PQ;
  const unsigned lds0 = (unsigned)(uintptr_t)shm;
  const bf16* ksrc = Kh + (long)lane * PQ + wid * 8;
  const bf16* vsrc = Vh + (long)(16 * (wid & 3) + (lane >> 2)) * PQ + (wid >> 2) * 32 + (lane & 3) * 8;
  const unsigned kdst = lds0 + LDS_K + wid * 1024, vdst = lds0 + LDS_V + wid * 1024;
#define DMA_K(t, slot) glds16(ksrc + (long)(t) * KVBLK * PQ, (unsigned)__builtin_amdgcn_readfirstlane(kdst + (slot)))
#define DMA_V(t, slot) glds16(vsrc + (long)(t) * KVBLK * PQ, (unsigned)__builtin_amdgcn_readfirstlane(vdst + (slot)))
  const int vb0 = (int)(lds0 + LDS_V) + ((lane >> 4) & 1) * 32 + (lane & 3) * 8 + (4 * hi + ((lane & 15) >> 2)) * 64;
  volatile LAS unsigned* flags = (volatile LAS unsigned*)((LAS char*)shm + LDS_WS);
  bf16x8 qr[4];
#pragma unroll
  for (int d0 = 0; d0 < 4; ++d0) qr[d0] = *reinterpret_cast<const bf16x8*>(&Qw[(long)r32 * PQ + d0 * 16 + hi * 8]);
  f32x16 o[2]; o[0] = f32x16{}; o[1] = f32x16{};
  const int qrel = wid * QBLK + r32;
  float arun = 0.f;
  const int jt = 4 * qb + 3;
  DMA_K(jt, 0); DMA_V(jt, 0);
  int slot = 0;
  for (int it = 0;; ++it) {
    const int tile = jt - it;
    const bool has_next = tile > 0;
    if (has_next) { DMA_K(tile - 1, (slot ^ 1) * SLOTB); DMA_V(tile - 1, (slot ^ 1) * SLOTB); WAIT_BAR(2); } else { WAIT_BAR(0); }
    const int jb = tile - 4 * qb;
    const bool active = (jb < 0) || (64 * jb < 32 * wid + 31);
    if (active) {
      f32x16 z0 = f32x16{}, z1 = f32x16{};
      qkt_acc(z0, z1, shm + LDS_K + slot * SLOTB, qr, r32, hi);
      if (jb >= 0) { const int kb = 64 * jb + 4 * hi;
#pragma unroll
        for (int r = 0; r < 16; ++r) { const int kv = kb + (r & 3) + 8 * (r >> 2); if (kv >= qrel) z0[r] = -INFINITY; if (kv + 32 >= qrel) z1[r] = -INFINITY; } }
      f32x16 k0, k1;
#pragma unroll
      for (int r = 0; r < 16; ++r) {
        { const float z = z0[r]; const float e = __builtin_amdgcn_exp2f(-__builtin_fabsf(z)); k0[r] = -(fmaxf(z, 0.f) + __builtin_amdgcn_logf(1.f + e)); }
        { const float z = z1[r]; const float e = __builtin_amdgcn_exp2f(-__builtin_fabsf(z)); k1[r] = -(fmaxf(z, 0.f) + __builtin_amdgcn_logf(1.f + e)); } }
      float s[2][4], ps[2][4];
#pragma unroll
      for (int g = 0; g < 4; ++g) { s[0][g] = (k0[4 * g] + k0[4 * g + 1]) + (k0[4 * g + 2] + k0[4 * g + 3]); s[1][g] = (k1[4 * g] + k1[4 * g + 1]) + (k1[4 * g + 2] + k1[4 * g + 3]); }
#pragma unroll
      for (int p = 0; p < 2; ++p)
#pragma unroll
        for (int g = 0; g < 4; ++g) ps[p][g] = xor32_partner(s[p][g], hi != 0);
      float suf = 0.f;
      float T[2][4];
#pragma unroll
      for (int p = 1; p >= 0; --p)
#pragma unroll
        for (int g = 3; g >= 0; --g) { T[p][g] = arun + suf + (hi == 0 ? ps[p][g] : 0.f); suf += s[p][g] + ps[p][g]; }
#pragma unroll
      for (int g = 0; g < 4; ++g) {
        { const float a3 = T[0][g], a2 = a3 + k0[4 * g + 3], a1 = a2 + k0[4 * g + 2], a0 = a1 + k0[4 * g + 1];
          z0[4 * g + 3] = __builtin_amdgcn_exp2f(z0[4 * g + 3] + k0[4 * g + 3] + a3); z0[4 * g + 2] = __builtin_amdgcn_exp2f(z0[4 * g + 2] + k0[4 * g + 2] + a2);
          z0[4 * g + 1] = __builtin_amdgcn_exp2f(z0[4 * g + 1] + k0[4 * g + 1] + a1); z0[4 * g]     = __builtin_amdgcn_exp2f(z0[4 * g] + k0[4 * g] + a0); }
        { const float a3 = T[1][g], a2 = a3 + k1[4 * g + 3], a1 = a2 + k1[4 * g + 2], a0 = a1 + k1[4 * g + 1];
          z1[4 * g + 3] = __builtin_amdgcn_exp2f(z1[4 * g + 3] + k1[4 * g + 3] + a3); z1[4 * g + 2] = __builtin_amdgcn_exp2f(z1[4 * g + 2] + k1[4 * g + 2] + a2);
          z1[4 * g + 1] = __builtin_amdgcn_exp2f(z1[4 * g + 1] + k1[4 * g + 1] + a1); z1[4 * g]     = __builtin_amdgcn_exp2f(z1[4 * g] + k1[4 * g] + a0); } }
      arun += suf;
      u32x4 w0, w1, w2, w3;
      w0 = (u32x4){cvtpk_s(z0[0], z0[1]), cvtpk_s(z0[2], z0[3]), cvtpk_s(z0[4], z0[5]), cvtpk_s(z0[6], z0[7])};
      w1 = (u32x4){cvtpk_s(z0[8], z0[9]), cvtpk_s(z0[10], z0[11]), cvtpk_s(z0[12], z0[13]), cvtpk_s(z0[14], z0[15])};
      w2 = (u32x4){cvtpk_s(z1[0], z1[1]), cvtpk_s(z1[2], z1[3]), cvtpk_s(z1[4], z1[5]), cvtpk_s(z1[6], z1[7])};
      w3 = (u32x4){cvtpk_s(z1[8], z1[9]), cvtpk_s(z1[10], z1[11]), cvtpk_s(z1[12], z1[13]), cvtpk_s(z1[14], z1[15])};
      pv(o, vb0 + slot * SLOTB, __builtin_bit_cast(bf16x8, w0), __builtin_bit_cast(bf16x8, w1), __builtin_bit_cast(bf16x8, w2), __builtin_bit_cast(bf16x8, w3));
    }
    const bool done_w = __all(arun < -152.f);
    if (lane == 0) flags[wid] = done_w ? 1u : 0u;
    asm volatile("s_waitcnt lgkmcnt(0)\n\ts_barrier" ::: "memory");
    unsigned alld = 1u;
#pragma unroll
    for (int w = 0; w < NW; ++w) alld &= flags[w];
    alld = __builtin_amdgcn_readfirstlane(alld);
    if (!has_next || alld) break;
    slot ^= 1;
  }
  asm volatile("s_waitcnt vmcnt(0)" ::: "memory");
  float ones[16];
#pragma unroll
  for (int r = 0; r < 16; ++r) ones[r] = 1.f;
  store_o<PO>(o, ones, Oh + (long)(q0 + wid * QBLK) * PO, shm, wid, lane, r32, hi);
  asm volatile("s_waitcnt vmcnt(0) lgkmcnt(0)\n\ts_barrier" ::: "memory");
#undef DMA_K
#undef DMA_V
}
#undef SBAR
#undef WAIT_BAR
}

#define XB_TMO      128
#define XB_XCNT(j)  (256  + 64 * (j))
#define XB_XSUB(j)  (1280 + 64 * (j))
#define XB_XGEN(j)  (2304 + 64 * (j))
#define XB_TOP      3328
#define XB_TOPGEN   3392
#define XCD_BAR_WORDS 3456
#define XB_SPIN_CAP (1u << 18)
__device__ __forceinline__ unsigned xb_ld(unsigned* p)              { return __hip_atomic_load(p, __ATOMIC_RELAXED, __HIP_MEMORY_SCOPE_AGENT); }
__device__ __forceinline__ unsigned xb_add(unsigned* p, unsigned v) { return __hip_atomic_fetch_add(p, v, __ATOMIC_RELAXED, __HIP_MEMORY_SCOPE_AGENT); }
__device__ __forceinline__ unsigned xb_xcc_id() { return (unsigned)__builtin_amdgcn_s_getreg((3 << 11) | 20) & 0xFu; }
#define XB_SPIN(cond, bar) do { unsigned _sp = 0; while (cond) { __builtin_amdgcn_s_sleep(1); \
    if ((++_sp & 255u) == 0u) { if (xb_ld(&(bar)[XB_TMO])) break; if (_sp > XB_SPIN_CAP) { atomicAdd(&(bar)[XB_TMO], 1u); break; } } } } while (0)
struct XcdBarrier { unsigned* bar; unsigned x; volatile LAS unsigned* st; };
__device__ __forceinline__ XcdBarrier xcd_barrier_post(unsigned* bar, volatile LAS unsigned* st) {
    XcdBarrier b; b.bar = bar; b.x = xb_xcc_id(); b.st = st;
    if (threadIdx.x == 0) (void)xb_add(&bar[XB_XCNT(b.x)], 1u);
    return b;
}
__device__ __forceinline__ void xcd_barrier_complete(unsigned* bar, unsigned x, unsigned& nloc, unsigned& nx) {
    const unsigned G = gridDim.x * gridDim.y * gridDim.z;
    unsigned sum, cnt, mine, sp = 0u;
    for (;;) {
        sum = 0u; cnt = 0u; mine = 0u;
#pragma unroll
        for (unsigned j = 0; j < 16; ++j) { const unsigned c = xb_ld(&bar[XB_XCNT(j)]); sum += c; cnt += (c > 0u) ? 1u : 0u; mine = (j == x) ? c : mine; }
        if (sum == G) break;
        __builtin_amdgcn_s_sleep(1);
        if ((++sp & 255u) == 0u) { if (xb_ld(&bar[XB_TMO])) break; if (sp > XB_SPIN_CAP) { atomicAdd(&bar[XB_TMO], 1u); break; } }
    }
    nloc = mine > 0u ? mine : 1u; nx = cnt > 0u ? cnt : 1u;
}
__device__ __forceinline__ void xcd_barrier(const XcdBarrier& b) {
    asm volatile("s_waitcnt vmcnt(0)" ::: "memory");
    __syncthreads();
    if (threadIdx.x == 0) {
        unsigned* bar = b.bar;
        __builtin_amdgcn_s_waitcnt(0);
        unsigned nloc = b.st[0], nx = b.st[1];
        if (nloc == 0u) { xcd_barrier_complete(bar, b.x, nloc, nx); b.st[0] = nloc; b.st[1] = nx; }
        const unsigned old = xb_add(&bar[XB_XSUB(b.x)], 1u);
        const unsigned gen = old / nloc;
        if (old + 1u == (gen + 1u) * nloc) {
            __builtin_amdgcn_fence(__ATOMIC_RELEASE, "agent");
            asm volatile("s_waitcnt vmcnt(0)" ::: "memory");
            const unsigned og = xb_add(&bar[XB_TOP], 1u);
            const unsigned tg = og / nx;
            if (og + 1u == (tg + 1u) * nx) xb_add(&bar[XB_TOPGEN], 1u);
            else XB_SPIN(xb_ld(&bar[XB_TOPGEN]) == tg, bar);
            __builtin_amdgcn_fence(__ATOMIC_ACQUIRE, "agent");
            xb_add(&bar[XB_XGEN(b.x)], 1u);
            asm volatile("s_waitcnt vmcnt(0)" ::: "memory");
        } else {
            XB_SPIN(xb_ld(&bar[XB_XGEN(b.x)]) == gen, bar);
            __builtin_amdgcn_fence(__ATOMIC_ACQUIRE, "agent");
            asm volatile("s_waitcnt vmcnt(0)" ::: "memory");
        }
    }
    __syncthreads();
}

struct Args { const float* in[24]; float* out; unsigned char* ws; };
struct Frame {
    LAS unsigned char* lds;
    int tid, lane, wave, vcu, G, bid;
};
#define CAS __attribute__((address_space(4)))
__device__ __forceinline__ const CAS char* karg_base() { const CAS char* p = (const CAS char*)__builtin_amdgcn_kernarg_segment_ptr(); asm volatile("" : "+s"(p)); return p; }
#define KIN(i) (*(const float* const CAS*)(karg_base() + 8 * (i)))
#define KOUT() (*(float* const CAS*)(karg_base() + 192))
#define KWS() (*(unsigned char* const CAS*)(karg_base() + 200))

__device__ __forceinline__ void p0_prologue(Frame& F) {
    const int gw = F.bid * NWAVES + F.wave, NGW = F.G * NWAVES, lane = F.lane;
    constexpr int N_GATE = 64 * 256, N_MOE = 3 * N_GATE, N_PROJ = 4 * 768, N_WOUT = 4 * 256, NITEMS = N_MOE + N_PROJ + N_WOUT;
    for (int it = gw; it < NITEMS; it += NGW) {
        const float* W; int pitch, nblk, item, kind; bf16_t* WT;
        if (it < N_MOE) { const int which = it / N_GATE, r = it % N_GATE, mat = r >> 8; item = r & 255; pitch = 1024; nblk = 16;
            W = KIN(21 + which) + (size_t)mat * 1048576;
            if (which < 2) { WT = (bf16_t*)(KWS() + WS_WGU) + (size_t)mat * 2097152; kind = 1 + which; } else { WT = (bf16_t*)(KWS() + WS_WD) + (size_t)mat * 1048576; kind = 0; } }
        else if (it < N_MOE + N_PROJ) { const int r = it - N_MOE, l = r / 768; item = r % 768; nblk = 48; kind = 3;
            if (l & 1) { W = KIN(12) + (size_t)(l >> 1) * 1024 * 3088; pitch = 3088; } else { W = KIN(3) + (size_t)(l >> 1) * 1024 * 3072; pitch = 3072; }
            WT = (bf16_t*)(KWS() + WS_WIN) + (size_t)l * 3145728; }
        else { const int r = it - N_MOE - N_PROJ, l = r >> 8; item = r & 255; nblk = 16; pitch = 1024; kind = 0;
            W = ((l & 1) ? KIN(16) : KIN(11)) + (size_t)(l >> 1) * 1048576; WT = (bf16_t*)(KWS() + WS_WOUT) + (size_t)l * 1048576; }
        const int nb = item % nblk, kb = item / nblk, n = nb * 64 + lane, k0 = kb * 64;
        int drow = n;
        if (kind == 1) drow = ((n >> 7) << 8) + (n & 127);
        else if (kind == 2) drow = ((n >> 7) << 8) + 128 + (n & 127);
        else if (kind == 3) { const int lb = (n >> 5) & 7, pb = 4 * (lb & 1) + (lb >> 1); drow = (n & ~255) + pb * 32 + (n & 31); }
        const float* src = W + (size_t)k0 * pitch + n;
        bf16_t* dst = WT + (size_t)drow * 1024 + k0;
#pragma unroll
        for (int h = 0; h < 2; ++h) {
            float v[32];
#pragma unroll
            for (int i = 0; i < 32; ++i) v[i] = src[(size_t)(h * 32 + i) * pitch];
#pragma unroll
            for (int c = 0; c < 4; ++c) { u32x4 w; w.x = cvt_pk_bf16(v[8 * c], v[8 * c + 1]); w.y = cvt_pk_bf16(v[8 * c + 2], v[8 * c + 3]); w.z = cvt_pk_bf16(v[8 * c + 4], v[8 * c + 5]); w.w = cvt_pk_bf16(v[8 * c + 6], v[8 * c + 7]);
                *(u32x4*)(dst + h * 32 + 8 * c) = w; }
        }
    }
}

__device__ __forceinline__ float reduce16(float (&v)[16], int lane) {
    { const bool b = (lane & 32) != 0;
#pragma unroll
      for (int i = 0; i < 8; ++i) { const float keep = b ? v[i + 8] : v[i], send = b ? v[i] : v[i + 8]; v[i] = keep + xor32_partner(send, b); } }
    { const bool b = (lane & 16) != 0;
#pragma unroll
      for (int i = 0; i < 4; ++i) { const float keep = b ? v[i + 4] : v[i], send = b ? v[i] : v[i + 4]; v[i] = keep + xor_swz<16>(send); } }
    { const bool b = (lane & 8) != 0;
#pragma unroll
      for (int i = 0; i < 2; ++i) { const float keep = b ? v[i + 2] : v[i], send = b ? v[i] : v[i + 2]; v[i] = keep + xor_swz<8>(send); } }
    { const bool b = (lane & 4) != 0; const float keep = b ? v[1] : v[0], send = b ? v[0] : v[1]; v[0] = keep + xor_swz<4>(send); }
    float r = v[0]; r += xor_swz<2>(r); r += xor_swz<1>(r); return r;
}
__device__ __forceinline__ float reduce4(float (&v)[4], int lane) {
    { const bool b = (lane & 32) != 0;
#pragma unroll
      for (int i = 0; i < 2; ++i) { const float keep = b ? v[i + 2] : v[i], send = b ? v[i] : v[i + 2]; v[i] = keep + xor32_partner(send, b); } }
    { const bool b = (lane & 16) != 0; const float keep = b ? v[1] : v[0], send = b ? v[0] : v[1]; v[0] = keep + xor_swz<16>(send); }
    float r = v[0]; r += xor_swz<8>(r); r += xor_swz<4>(r); r += xor_swz<2>(r); r += xor_swz<1>(r); return r;
}

struct RowArgs {
    const float* xin; float* xres; const float* gain; bf16_t* XN;
    const bf16_t* Y; const int* r_e; const int* r_rel; const float* r_w; const unsigned* cnt_prev;
    bool fgate; const float* wf; const float* bf; float* logf;
    const float* wr; const float* br; const float* wg; const float* bg;
    int* o_e; int* o_rel; float* o_w; unsigned* cnt; int* lists;
};
template <int MODE> __device__ __forceinline__ void row_phase(Frame& F, const RowArgs& R) {
    LAS float* wt = (LAS float*)F.lds;
    LAS int* rt_e = (LAS int*)(F.lds + 81920);
    LAS float* rt_w = (LAS float*)(F.lds + 81920 + 512);
    LAS int* rt_rank = (LAS int*)(F.lds + 81920 + 1024);
    LAS int* hist = (LAS int*)(F.lds + 81920 + 1536);
    LAS int* pbase = (LAS int*)(F.lds + MOETAB_OFF + 256);
    const int lane = F.lane, tid = F.tid;
    constexpr bool COMBINE = (MODE == 1 || MODE == 3), ROUTER = (MODE == 2), NORM = (MODE != 3);
    const bool fgate = (MODE <= 1) && R.fgate;
    if (ROUTER) {
        for (int k = tid; k < 1024; k += NWAVES * 64) {
            const f32x4* s = (const f32x4*)(R.wr + (size_t)k * 16);
#pragma unroll
            for (int q = 0; q < 4; ++q) { const f32x4 v = s[q]; wt[(4 * q) * 1024 + k] = v[0]; wt[(4 * q + 1) * 1024 + k] = v[1]; wt[(4 * q + 2) * 1024 + k] = v[2]; wt[(4 * q + 3) * 1024 + k] = v[3]; }
            const f32x4 g = *(const f32x4*)(R.wg + (size_t)k * 4); wt[16 * 1024 + k] = g[0]; wt[17 * 1024 + k] = g[1]; wt[18 * 1024 + k] = g[2]; wt[19 * 1024 + k] = g[3];
        }
        if (tid < 32) hist[tid] = 0;
    }
    if (fgate) {
        for (int k = tid; k < 1024; k += NWAVES * 64) {
            const f32x4* s = (const f32x4*)(R.wf + (size_t)k * 3088);
#pragma unroll
            for (int q = 0; q < 4; ++q) { const f32x4 v = s[q]; wt[(4 * q) * 1024 + k] = v[0]; wt[(4 * q + 1) * 1024 + k] = v[1]; wt[(4 * q + 2) * 1024 + k] = v[2]; wt[(4 * q + 3) * 1024 + k] = v[3]; }
        }
    }
    if (COMBINE) {
        if (tid == 0) { int acc = 0; for (int e = 0; e < 16; ++e) { pbase[e] = acc; acc += (((int)R.cnt_prev[e] + 255) >> 8) << 8; } }
    }
    __syncthreads();
    f32x4 g4[4];
    if (NORM) {
#pragma unroll
        for (int j = 0; j < 4; ++j) g4[j] = *(const f32x4*)(R.gain + 4 * lane + 256 * j);
    }
    for (int blk = F.bid; blk < M / 64; blk += F.G) {
#pragma unroll 1
        for (int rr = 0; rr < 8; ++rr) {
            const int lrow = F.wave * 8 + rr, row = blk * 64 + lrow;
            const f32x4* xr = (const f32x4*)((MODE == 0 ? R.xin : (const float*)R.xres) + (size_t)row * DM) + lane;
            f32x4 x4[4];
#pragma unroll
            for (int j = 0; j < 4; ++j) x4[j] = xr[64 * j];
            if (COMBINE) {
#pragma unroll
                for (int k = 0; k < 2; ++k) {
                    const int e = R.r_e[row * 2 + k], rel = R.r_rel[row * 2 + k]; const float w = R.r_w[row * 2 + k];
                    const size_t pos = (size_t)(pbase[e] + rel);
                    const u32x2* yr = (const u32x2*)(R.Y + pos * DM) + lane;
#pragma unroll
                    for (int j = 0; j < 4; ++j) { const u32x2 y = yr[64 * j]; x4[j][0] += w * bf_lo(y.x); x4[j][1] += w * bf_hi(y.x); x4[j][2] += w * bf_lo(y.y); x4[j][3] += w * bf_hi(y.y); }
                }
            }
            if (MODE != 2) { f32x4* xo = (f32x4*)(R.xres + (size_t)row * DM) + lane;
#pragma unroll
                for (int j = 0; j < 4; ++j) xo[64 * j] = x4[j]; }
            if (NORM) {
                float ss = 0.f;
#pragma unroll
                for (int j = 0; j < 4; ++j) ss += (x4[j][0] * x4[j][0] + x4[j][1] * x4[j][1]) + (x4[j][2] * x4[j][2] + x4[j][3] * x4[j][3]);
                const float rstd = __builtin_amdgcn_rsqf(wave_sum(ss) * (1.f / DM) + EPS);
#pragma unroll
                for (int j = 0; j < 4; ++j) x4[j] = x4[j] * rstd * g4[j];
                u32x2* xo = (u32x2*)(R.XN + (size_t)row * DM) + lane;
#pragma unroll
                for (int j = 0; j < 4; ++j) { u32x2 w; w.x = cvt_pk_bf16(x4[j][0], x4[j][1]); w.y = cvt_pk_bf16(x4[j][2], x4[j][3]); xo[64 * j] = w; }
                if (fgate || ROUTER) {
                    float d[16];
#pragma unroll
                    for (int c = 0; c < 16; ++c) { float a = 0.f;
#pragma unroll
                        for (int j = 0; j < 4; ++j) { const f32x4 w = *(const LAS f32x4*)(wt + c * 1024 + 256 * j + 4 * lane); a += (x4[j][0] * w[0] + x4[j][1] * w[1]) + (x4[j][2] * w[2] + x4[j][3] * w[3]); }
                        d[c] = a; }
                    const float rl = reduce16(d, lane);
                    if (fgate) {
                        const int h = lane >> 2; const float z = rl + R.bf[h];
                        const float ls = fminf(z, 0.f) - 0.6931471805599453f * __builtin_amdgcn_logf(1.f + __builtin_amdgcn_exp2f(-fabsf(z) * LOG2E));
                        if ((lane & 3) == 0) R.logf[(size_t)row * 16 + h] = ls;
                    }
                    if (ROUTER) {
                        float dg[4];
#pragma unroll
                        for (int c = 0; c < 4; ++c) { float a = 0.f;
#pragma unroll
                            for (int j = 0; j < 4; ++j) { const f32x4 w = *(const LAS f32x4*)(wt + (16 + c) * 1024 + 256 * j + 4 * lane); a += (x4[j][0] * w[0] + x4[j][1] * w[1]) + (x4[j][2] * w[2] + x4[j][3] * w[3]); }
                            dg[c] = a; }
                        const float gl_ = reduce4(dg, lane);
                        float gl[4];
#pragma unroll
                        for (int c = 0; c < 4; ++c) gl[c] = __int_as_float(__builtin_amdgcn_readlane(__float_as_int(gl_), 16 * c)) + R.bg[c];
                        int gi = 0; float gm = gl[0];
#pragma unroll
                        for (int c = 1; c < 4; ++c) if (gl[c] > gm) { gm = gl[c]; gi = c; }
                        float gs = 0.f;
#pragma unroll
                        for (int c = 0; c < 4; ++c) gs += __builtin_amdgcn_exp2f((gl[c] - gm) * LOG2E);
                        const float gw = __builtin_amdgcn_rcpf(gs);
                        gi = __builtin_amdgcn_readfirstlane(gi);
                        float el[4];
#pragma unroll
                        for (int c = 0; c < 4; ++c) el[c] = __int_as_float(__builtin_amdgcn_readlane(__float_as_int(rl), 4 * (4 * gi + c))) + R.br[4 * gi + c];
                        int i0 = 0; float v0 = el[0];
#pragma unroll
                        for (int c = 1; c < 4; ++c) if (el[c] > v0) { v0 = el[c]; i0 = c; }
                        int i1 = -1; float v1 = -INFINITY;
#pragma unroll
                        for (int c = 0; c < 4; ++c) if (c != i0 && el[c] > v1) { v1 = el[c]; i1 = c; }
                        const float p0 = __builtin_amdgcn_rcpf(1.f + __builtin_amdgcn_exp2f((v1 - v0) * LOG2E));
                        if (lane == 0) { rt_e[2 * lrow] = 4 * gi + i0; rt_e[2 * lrow + 1] = 4 * gi + i1; rt_w[2 * lrow] = p0 * gw; rt_w[2 * lrow + 1] = (1.f - p0) * gw; }
                    }
                }
            }
        }
        if (ROUTER) {
            __syncthreads();
            int e = 0;
            if (tid < 128) { e = rt_e[tid]; rt_rank[tid] = atomicAdd((int*)(hist + e), 1); }
            __syncthreads();
            if (tid < 16) hist[16 + tid] = (int)atomicAdd(R.cnt + tid, (unsigned)hist[tid]);
            __syncthreads();
            if (tid < 128) { const int row = blk * 64 + (tid >> 1), k = tid & 1, rel = hist[16 + e] + rt_rank[tid];
                R.o_e[row * 2 + k] = e; R.o_rel[row * 2 + k] = rel; R.o_w[row * 2 + k] = rt_w[tid]; R.lists[e * LISTCAP + rel] = row; }
            __syncthreads();
            if (tid < 16) hist[tid] = 0;
            __syncthreads();
        }
    }
}

__device__ __forceinline__ void cumsum_phase(Frame& F, const float* logf, float* ftabg) {
    LAS float* tot = (LAS float*)F.lds;
    for (int bh = F.bid; bh < 32; bh += F.G) {
        const int b = bh >> 4, h = bh & 15, t0 = F.tid * 16;
        float v[16]; float run = 0.f;
#pragma unroll
        for (int j = 0; j < 16; ++j) { run += logf[(size_t)(b * SEQ + t0 + j) * 16 + h]; v[j] = run; }
        tot[F.tid] = run;
        __syncthreads();
        if (F.tid < 8) { float a = 0.f; for (int j = 0; j < 64; ++j) a += tot[F.tid * 64 + j]; tot[512 + F.tid] = a; }
        __syncthreads();
        float base = 0.f;
        for (int w = 0; w < F.wave; ++w) base += tot[512 + w];
        for (int j = 0; j < 63; ++j) { const float u = tot[F.wave * 64 + j]; base += (j < F.lane) ? u : 0.f; }
        float* dst = ftabg + (size_t)bh * SEQ + t0;
#pragma unroll
        for (int j = 0; j < 16; j += 4) *(f32x4*)(dst + j) = (f32x4){(base + v[j]) * LOG2E, (base + v[j + 1]) * LOG2E, (base + v[j + 2]) * LOG2E, (base + v[j + 3]) * LOG2E};
        __syncthreads();
    }
}

__device__ __forceinline__ void acombine_phase(Frame& F, const bf16_t* AO, bf16_t* O, const float* lq1, const float* lk1, const float* lq2, const float* lk2, const float* subg, float lam_init) {
    const int lane = F.lane;
    const float s1 = wave_sum(lq1[lane] * lk1[lane]), s2 = wave_sum(lq2[lane] * lk2[lane]);
    const float lam = __builtin_amdgcn_exp2f(s1 * LOG2E) - __builtin_amdgcn_exp2f(s2 * LOG2E) + lam_init, osc = 1.f - lam_init;
    const int hA = lane >> 4, j0 = (lane & 15) * 8;
    float g[8];
#pragma unroll
    for (int i = 0; i < 8; ++i) g[i] = subg[j0 + i] * osc;
    const int gw = F.bid * NWAVES + F.wave, NGW = F.G * NWAVES;
    for (int row = gw; row < M; row += NGW) {
        const u32x4 a = *(const u32x4*)(AO + (size_t)row * DM + hA * 256 + j0), b = *(const u32x4*)(AO + (size_t)row * DM + hA * 256 + 128 + j0);
        float d[8];
        d[0] = bf_lo(a.x) - lam * bf_lo(b.x); d[1] = bf_hi(a.x) - lam * bf_hi(b.x); d[2] = bf_lo(a.y) - lam * bf_lo(b.y); d[3] = bf_hi(a.y) - lam * bf_hi(b.y);
        d[4] = bf_lo(a.z) - lam * bf_lo(b.z); d[5] = bf_hi(a.z) - lam * bf_hi(b.z); d[6] = bf_lo(a.w) - lam * bf_lo(b.w); d[7] = bf_hi(a.w) - lam * bf_hi(b.w);
        float ss = 0.f;
#pragma unroll
        for (int i = 0; i < 8; ++i) ss += d[i] * d[i];
        ss += xor_swz<1>(ss); ss += xor_swz<2>(ss); ss += xor_swz<4>(ss); ss += xor_swz<8>(ss);
        const float rstd = __builtin_amdgcn_rsqf(ss * (1.f / 128.f) + EPS);
        u32x4 w; w.x = cvt_pk_bf16(d[0] * rstd * g[0], d[1] * rstd * g[1]); w.y = cvt_pk_bf16(d[2] * rstd * g[2], d[3] * rstd * g[3]);
        w.z = cvt_pk_bf16(d[4] * rstd * g[4], d[5] * rstd * g[5]); w.w = cvt_pk_bf16(d[6] * rstd * g[6], d[7] * rstd * g[7]);
        *(u32x4*)(O + (size_t)row * DM + hA * 128 + j0) = w;
    }
}

__global__ void __launch_bounds__(NWAVES * 64, 2) hybrid_fwd(Args args_unused) {
    extern __shared__ __attribute__((aligned(16))) unsigned char lds[];
    Frame F;
    F.lds = (LAS unsigned char*)lds;
    const int wave_s = __builtin_amdgcn_readfirstlane((int)threadIdx.x >> 6);
    F.tid = threadIdx.x; F.lane = F.tid & 63; F.wave = wave_s;
    F.G = gridDim.x; F.bid = blockIdx.x; { const int bx = blockIdx.x; F.vcu = (F.G % 8 == 0) ? (bx % 8) * (F.G / 8) + bx / 8 : bx; }
#define WSB KWS()
#define CTLP ((unsigned*)(KWS() + WS_CTL))
    volatile LAS unsigned* MISC = (volatile LAS unsigned*)(F.lds + MISC_OFF);
    for (int u = F.tid; u < (LDS_BYTES - LDSCTL_OFF) / 4; u += NWAVES * 64) ((LAS unsigned*)(F.lds + LDSCTL_OFF))[u] = 0u;
    __syncthreads();
    (void)xcd_barrier_post(CTLP + CW_BAR, MISC + 8);
#define RELAUNDER() do { int l_; asm volatile("v_mbcnt_lo_u32_b32 %0, -1, 0\n\tv_mbcnt_hi_u32_b32 %0, -1, %0" : "=&v"(l_)); F.lane = l_; F.tid = wave_s * 64 + l_; F.wave = wave_s; } while (0)
#define GRID_BAR() do { XcdBarrier b_; b_.bar = CTLP + CW_BAR; b_.x = xb_xcc_id(); b_.st = MISC + 8; xcd_barrier(b_); RELAUNDER(); } while (0)

#define P_XN ((bf16_t*)(WSB + WS_XN))
#define P_QKV ((bf16_t*)(WSB + WS_QKV))
#define P_OB ((bf16_t*)(WSB + WS_O))
#define P_AO ((bf16_t*)(WSB + WS_AO))
#define P_HB ((bf16_t*)(WSB + WS_H))
#define P_YB ((bf16_t*)(WSB + WS_Y))
#define P_FTABG ((float*)(WSB + WS_FTAB))
#define P_LOGF ((float*)(WSB + WS_LOGF))
#define P_RE ((int*)(WSB + WS_ROUTE))
#define P_RREL (P_RE + 2 * M)
#define P_RW ((float*)(P_RREL + 2 * M))
#define P_LISTS ((int*)(WSB + WS_LISTS))
    LAS float* gtab = (LAS float*)(F.lds + GTAB_OFF);
    LAS int* moetab = (LAS int*)(F.lds + MOETAB_OFF);

#ifndef SK_P0
    p0_prologue(F);
#endif
    GRID_BAR();

#pragma unroll 1
    for (int layer = 0; layer < DEPTH; ++layer) {
        const int li = layer >> 1; const bool odd = (layer & 1) != 0;
        {
            RowArgs R{};
            R.xin = KIN(0); R.xres = KOUT(); R.gain = KIN(1) + layer * DM; R.XN = P_XN;
            R.Y = P_YB; R.r_e = P_RE; R.r_rel = P_RREL; R.r_w = P_RW; R.cnt_prev = CTLP + CW_CNT + 64 * (layer > 0 ? layer - 1 : 0);
            R.fgate = odd; R.wf = KIN(12) + (size_t)li * 1024 * 3088 + 3072; R.bf = KIN(13) + li * 16; R.logf = P_LOGF;
#ifndef SK_N1
            if (layer == 0) row_phase<0>(F, R); else row_phase<1>(F, R);
#endif
        }
        GRID_BAR();
        {
            if (odd) cumsum_phase(F, P_LOGF, P_FTABG);
            if (F.tid < 128) { const float* gq = odd ? KIN(14) + li * 64 : KIN(4) + li * 64; const float* gk = odd ? KIN(15) + li * 64 : KIN(5) + li * 64;
                gtab[F.tid] = F.tid < 64 ? gq[F.tid] * C2 : gk[F.tid - 64]; }
            __syncthreads();
            pg8::ProjSched S; S.so.init(M, NQKV, F.G, F.bid); S.A = (const char*)P_XN; S.W = (const char*)(WSB + WS_WIN) + (size_t)layer * 3145728 * 2;
            if (odd) { S.mq = 4; S.mk = 8; S.s_lo = 0; S.s_hi = 0; } else { S.mq = 2; S.mk = 4; S.s_lo = 6; S.s_hi = 8; }
            pg8::EpiProj E{P_QKV, gtab};
#ifndef SK_PROJ
            pg8::gemm_phase<pg8::EpiProj, pg8::ProjSched, false>(F.lds, S, E, F.tid);
#endif
        }
        GRID_BAR();
        {
            using abf = att::bf16;
            const float* gq = odd ? KIN(14) + li * 64 : KIN(4) + li * 64; const float* gk = odd ? KIN(15) + li * 64 : KIN(5) + li * 64;
            const float Bp = 1.03f * 8.f * wave_max(fabsf(gq[F.lane])) * wave_max(fabsf(gk[F.lane])) * LOG2E + 0.5f;
            LAS float* ftab = (LAS float*)(F.lds + att::LDS_FTAB);
            for (int vh = F.vcu >> 3; vh < 32; vh += (F.G >> 3)) {
                int tf = F.tid; asm volatile("" : "+v"(tf));
                const int b = vh >> 4;
                const abf *Qh, *Kh, *Vh; abf* Oh;
                const abf* base = (const abf*)P_QKV + (size_t)b * SEQ * PQ;
                if (odd) { const int h = vh & 15; Qh = base + h * 64; Kh = base + 1024 + h * 64; Vh = base + 2048 + h * 64; Oh = (abf*)P_OB + (size_t)b * SEQ * DM + h * 64;
                    const f32x4* src = (const f32x4*)(P_FTABG + (size_t)vh * SEQ);
                    for (int i = tf; i < SEQ / 4; i += NWAVES * 64) ((LAS f32x4*)ftab)[i] = src[i];
                } else { const int hA = (vh >> 2) & 3, mp = (vh >> 1) & 1, vhalf = vh & 1;
                    Qh = base + hA * 128 + mp * 64; Kh = base + 512 + hA * 128 + mp * 64; Vh = base + 1024 + hA * 128 + vhalf * 64; Oh = (abf*)P_AO + (size_t)b * SEQ * DM + hA * 256 + mp * 128 + vhalf * 64;
                    const float slope = __builtin_amdgcn_exp2f(-2.f * (float)(hA + 1)) * LOG2E;
                    for (int i = tf; i < SEQ; i += NWAVES * 64) ftab[i] = -slope * (float)i;
                }
                __syncthreads();
                const int s = F.vcu & 7;
#pragma unroll 1
                for (int i = 0; i < 4; ++i) { const int qb = (i == 0) ? s : (i == 1) ? 15 - s : (i == 2) ? 16 + s : 31 - s;
#ifndef SK_ATT
                    { int t_ = F.tid; asm volatile("" : "+v"(t_)); att::attn_unit_b<DM>(qb, Qh, Kh, Vh, Oh, Bp, (char*)lds, t_); }
#endif
 }
                __syncthreads();
            }
            if (!odd) {
#pragma unroll 1
                for (int u = F.vcu; u < 512; u += F.G) {
                    const int uu = (u & 255) * 2 + (u >> 8);
                    const int bh = uu >> 5, qb = uu & 31, b = bh >> 3, hB = bh & 7;
                    const abf* base = (const abf*)P_QKV + (size_t)b * SEQ * PQ;
#ifndef SK_SB
                    int t_ = F.tid; asm volatile("" : "+v"(t_));
                    att::sb_unit<DM>(qb, base + 1536 + hB * 64, base + 2048 + hB * 64, base + 2560 + hB * 64, (abf*)P_OB + (size_t)b * SEQ * DM + 512 + hB * 64, (char*)lds, t_);
#endif
                }
            }
        }
        GRID_BAR();
        if (!odd) {
            const float lam_init = 0.8f - 0.6f * __builtin_amdgcn_exp2f(-0.3f * LOG2E * (float)layer);
            acombine_phase(F, P_AO, P_OB, KIN(6) + li * 64, KIN(7) + li * 64, KIN(8) + li * 64, KIN(9) + li * 64, KIN(10) + li * 128, lam_init);
            GRID_BAR();
        }
        {
            pg8::WoutSched S; S.so.init(M, DM, F.G, F.bid); S.A = (const char*)P_OB; S.W = (const char*)(WSB + WS_WOUT) + (size_t)layer * 1048576 * 2;
            pg8::EpiResid E{KOUT()};
#ifndef SK_WOUT
            pg8::gemm_phase<pg8::EpiResid, pg8::WoutSched, false>(F.lds, S, E, F.tid);
#endif
        }
        GRID_BAR();
        {
            RowArgs R{};
            R.xin = KIN(0); R.xres = KOUT(); R.gain = KIN(2) + layer * DM; R.XN = P_XN;
            R.wr = KIN(19) + (size_t)layer * 1024 * 16; R.br = KIN(20) + layer * 16; R.wg = KIN(17) + (size_t)layer * 1024 * 4; R.bg = KIN(18) + layer * 4;
            R.o_e = P_RE; R.o_rel = P_RREL; R.o_w = P_RW; R.cnt = CTLP + CW_CNT + 64 * layer; R.lists = P_LISTS;
#ifndef SK_N2
            row_phase<2>(F, R);
#endif
        }
        GRID_BAR();
        {
            if (F.tid == 0) { int acc = 0; for (int e = 0; e < 16; ++e) { const int c = (int)CTLP[CW_CNT + 64 * layer + e]; moetab[e] = acc; moetab[17 + e] = c; acc += (c + 255) >> 8; } moetab[16] = acc; }
            __syncthreads();
            pg8::MoeSched<8, true> S{moetab, F.G, F.bid, (const char*)P_XN, (const char*)(WSB + WS_WGU) + (size_t)layer * 16 * 2097152 * 2, P_LISTS};
            pg8::EpiSwiGLU E{P_HB};
#ifndef SK_UP
            pg8::gemm_phase<pg8::EpiSwiGLU, pg8::MoeSched<8, true>, true>(F.lds, S, E, F.tid);
#endif
        }
        GRID_BAR();
        {
            pg8::MoeSched<4, false> S{moetab, F.G, F.bid, (const char*)P_HB, (const char*)(WSB + WS_WD) + (size_t)layer * 16 * 1048576 * 2, P_LISTS};
            pg8::EpiBf16 E{P_YB};
#ifndef SK_DOWN
            pg8::gemm_phase<pg8::EpiBf16, pg8::MoeSched<4, false>, false>(F.lds, S, E, F.tid);
#endif
        }
        GRID_BAR();
    }
    {
        RowArgs R{};
        R.xin = KIN(0); R.xres = KOUT(); R.gain = KIN(1); R.XN = P_XN;
        R.Y = P_YB; R.r_e = P_RE; R.r_rel = P_RREL; R.r_w = P_RW; R.cnt_prev = CTLP + CW_CNT + 64 * (DEPTH - 1);
#ifndef SK_N3
        row_phase<3>(F, R);
#endif
    }
    if (xb_ld(CTLP + CW_BAR + XB_TMO) != 0u) {
        VM_WAIT(); __syncthreads();
        const float qn = __builtin_nanf("");
        for (size_t i = (size_t)F.bid * 512 + F.tid; i < (size_t)M * DM; i += (size_t)F.G * 512) KOUT()[i] = qn;
    }
#undef GRID_BAR
}

#undef P_XN
#undef P_QKV
#undef P_OB
#undef P_AO
#undef P_HB
#undef P_YB
#undef P_FTABG
#undef P_LOGF
#undef P_RE
#undef P_RREL
#undef P_RW
#undef P_LISTS
#undef WSB
#undef CTLP
extern "C" void kernel_launch(void* const* d_in, const int* in_sizes, int n_in, void* d_out, int out_size, void* d_ws, size_t ws_size, hipStream_t stream) {
    static int grid = 0;
    if (grid == 0) {
        if (n_in != 24 || in_sizes[0] != M * DM || out_size != M * DM || ws_size < WS_END) { fprintf(stderr, "kernel_launch: unexpected shapes (n_in %d, in0 %d, out %d, ws %zu); nothing launched\n", n_in, n_in > 0 ? in_sizes[0] : -1, out_size, ws_size); grid = -1; return; }
        int dev = 0, cus = 0, per_cu = 0;
        if (hipGetDevice(&dev) != hipSuccess || hipDeviceGetAttribute(&cus, hipDeviceAttributeMultiprocessorCount, dev) != hipSuccess) { grid = -1; return; }
        if (hipFuncSetAttribute((const void*)hybrid_fwd, hipFuncAttributeMaxDynamicSharedMemorySize, LDS_BYTES) != hipSuccess) { fprintf(stderr, "kernel_launch: hipFuncSetAttribute failed\n"); grid = -1; return; }
        if (hipOccupancyMaxActiveBlocksPerMultiprocessor(&per_cu, (const void*)hybrid_fwd, NWAVES * 64, LDS_BYTES) != hipSuccess || per_cu < 1)
            fprintf(stderr, "kernel_launch: note: occupancy query reports %d workgroups per CU\n", per_cu);
        (void)hipGetLastError();
        grid = cus;
        if (grid != 256) fprintf(stderr, "kernel_launch: %d CUs; the attention schedule assumes 256\n", grid);
    }
    if (grid < 0) return;
    if (hipMemsetAsync((char*)d_ws + WS_CTL, 0, CTL_ZERO_BYTES, stream) != hipSuccess) return;
    Args a{};
    for (int i = 0; i < 24; ++i) a.in[i] = (const float*)d_in[i];
    a.out = (float*)d_out; a.ws = (unsigned char*)d_ws;
    hipLaunchKernelGGL(hybrid_fwd, dim3(grid), dim3(NWAVES * 64), LDS_BYTES, stream, a);
}
```

```cpp
#include <hip/hip_runtime.h>
#include <hip/hip_bf16.h>
#include <cstdio>
#include <cstdint>
#include <cmath>

#define GAS __attribute__((address_space(1)))
#define LAS __attribute__((address_space(3)))
typedef unsigned short bf16_t;
typedef short bf16x8 __attribute__((ext_vector_type(8)));
typedef short s16x4 __attribute__((ext_vector_type(4)));
typedef float f32x2 __attribute__((ext_vector_type(2)));
typedef float f32x4 __attribute__((ext_vector_type(4)));
typedef float f32x16 __attribute__((ext_vector_type(16)));
typedef unsigned u32x2 __attribute__((ext_vector_type(2)));
typedef unsigned u32x4 __attribute__((ext_vector_type(4)));

constexpr int BATCH = 2, SEQ = 8192, DM = 1024, M = BATCH * SEQ, DEPTH = 4;
constexpr int NQKV = 3072, PQ = 3072;
constexpr int NEXP = 16, LISTCAP = 16384, PMAX = 36864;
constexpr float EPS = 1e-6f;
constexpr float LOG2E = 1.4426950408889634f, C2 = 0.125f * LOG2E;
constexpr int NWAVES = 8;
#ifndef PROBE
#define PROBE 0
#endif
constexpr int REP_P0 = (PROBE == 1) ? 2 : 1, REP_PROJ = (PROBE == 2) ? 2 : 1, REP_ATT_EVEN = (PROBE == 3) ? 2 : 1, REP_SB = (PROBE == 4) ? 2 : 1, REP_ATT_ODD = (PROBE == 5) ? 2 : 1,
              REP_UP = (PROBE == 6) ? 2 : 1, REP_DOWN = (PROBE == 7) ? 2 : 1, REP_ACOMB = (PROBE == 8) ? 2 : 1;

constexpr size_t MiB = 1u << 20;
constexpr size_t WS_CTL = 0, CTL_ZERO_BYTES = 1 * MiB;
constexpr size_t WS_FTAB = 2 * MiB;
constexpr size_t WS_LOGF = 3 * MiB;
constexpr size_t WS_ROUTE = 4 * MiB;
constexpr size_t WS_LISTS = 5 * MiB;
constexpr size_t WS_JS = 6 * MiB;
constexpr size_t WS_WIN = 8 * MiB;
constexpr size_t WS_WOUT = 32 * MiB;
constexpr size_t WS_WGU = 40 * MiB;
constexpr size_t WS_WD = 296 * MiB;
constexpr size_t WS_XN = 424 * MiB;
constexpr size_t WS_QKV = 456 * MiB;
constexpr size_t WS_O = 552 * MiB;
constexpr size_t WS_AO = 584 * MiB;
constexpr size_t WS_H = 616 * MiB;
constexpr size_t WS_Y = 688 * MiB;
constexpr size_t WS_END = 760 * MiB;
constexpr int CW_BAR = 4096;
constexpr int CW_CNT = 1024;
constexpr int CW_ATTQ = 8192;

constexpr int RING_BYTES = 131072;
constexpr int LDSCTL_OFF = RING_BYTES, MISC_OFF = LDSCTL_OFF + 320;
constexpr int GTAB_OFF = LDSCTL_OFF + 1024;
constexpr int MOETAB_OFF = LDSCTL_OFF + 2048;
constexpr int JSL_OFF = LDSCTL_OFF + 4096;
constexpr int LDS_BYTES = 147456;

#define RLX_AGENT __ATOMIC_RELAXED, __HIP_MEMORY_SCOPE_AGENT
#define LDS_WAIT() asm volatile("s_waitcnt lgkmcnt(0)" ::: "memory")
#define VM_WAIT() asm volatile("s_waitcnt vmcnt(0)" ::: "memory")
__device__ __forceinline__ unsigned cvt_pk_bf16(float lo, float hi) { unsigned r; asm volatile("v_cvt_pk_bf16_f32 %0, %1, %2" : "=v"(r) : "v"(lo), "v"(hi)); return r; }
__device__ __forceinline__ float bf_lo(unsigned u) { return __uint_as_float(u << 16); }
__device__ __forceinline__ float bf_hi(unsigned u) { return __uint_as_float(u & 0xffff0000u); }
template <int MSK> __device__ __forceinline__ float xor_swz(float v) { return __int_as_float(__builtin_amdgcn_ds_swizzle(__float_as_int(v), (MSK << 10) | 0x1F)); }
__device__ __forceinline__ float xor32_partner(float v, bool upper) { auto rr = __builtin_amdgcn_permlane32_swap(__float_as_uint(v), __float_as_uint(v), false, false); return __uint_as_float(upper ? rr[0] : rr[1]); }
__device__ __forceinline__ float xor32_sum(float v) { auto rr = __builtin_amdgcn_permlane32_swap(__float_as_uint(v), __float_as_uint(v), false, false); return __uint_as_float(rr[0]) + __uint_as_float(rr[1]); }
__device__ __forceinline__ float wave_sum(float v) {
    v += xor_swz<1>(v); v += xor_swz<2>(v); v += xor_swz<4>(v); v += xor_swz<8>(v); v += xor_swz<16>(v); return xor32_sum(v);
}
__device__ __forceinline__ float wave_max(float v) {
    v = fmaxf(v, xor_swz<1>(v)); v = fmaxf(v, xor_swz<2>(v)); v = fmaxf(v, xor_swz<4>(v)); v = fmaxf(v, xor_swz<8>(v)); v = fmaxf(v, xor_swz<16>(v));
    auto rr = __builtin_amdgcn_permlane32_swap(__float_as_uint(v), __float_as_uint(v), false, false); return fmaxf(__uint_as_float(rr[0]), __uint_as_float(rr[1]));
}

namespace pg8 {
constexpr int BM = 256, BK = 64, HALF = 128, HTB = HALF * BK * 2, STAGE_BYTES = 8 * HTB, NXCD = 8, WGM = 8, K = 1024;
__host__ __device__ __forceinline__ int lds_byte(int r, int c) { const int st = (r >> 4) * 2 + (c >> 5), rr = r & 15, cc = c & 31, ob = rr * 64 + cc * 2; return st * 1024 + (ob ^ (((ob >> 9) & 1) << 5)); }
__host__ __device__ __forceinline__ void stage_rc(int b, int& R, int& C) { const int st = b / 1024, sb = b % 1024, swz = sb ^ (((sb >> 9) & 1) << 5); R = (st >> 1) * 16 + swz / 64; C = (st & 1) * 32 + (swz % 64) / 2; }
__host__ __device__ __forceinline__ int perm32(int rho) { const int n = rho >> 4, i = rho & 15; return 8 * (i >> 2) + 4 * n + (i & 3); }

struct Unit {
    const char* a;
    const char* b;
    const int* list;
    int nvalid;
    int row0, col0;
    int mode;
};

struct StaticOrder {
    int nM, nN, nwg, G, c;
    __device__ void init(int M_, int N_, int G_, int c_) { nM = M_ / BM; nN = N_ / BM; nwg = nM * nN; G = G_; c = c_; }
    __device__ bool next(int i, int& pm, int& pn) const {
        const long L = (long)i * G + c; if (L >= nwg) return false;
        int wgid = (int)L; { const int q = nwg / NXCD, r = nwg % NXCD, xcd = wgid % NXCD, off = wgid / NXCD; wgid = (xcd < r ? xcd * (q + 1) : r * (q + 1) + (xcd - r) * q) + off; }
        const int nig = WGM * nN, gid = wgid / nig, fm = gid * WGM, gsz = (nM - fm) < WGM ? (nM - fm) : WGM;
        pm = fm + ((wgid % nig) % gsz); pn = (wgid % nig) / gsz; return true;
    }
};

typedef f32x4 Acc[2][2][4][2];

template <class Epi, class Sched, bool GATHER>
__device__ __forceinline__ void gemm_phase(LAS unsigned char* lds, const Sched& S, const Epi& E, const int tid) {
    const int wid = __builtin_amdgcn_readfirstlane(tid >> 6), lane = tid & 63, wr = wid >> 2, wc = wid & 3, fr = lane & 15, fq = lane >> 4;
    constexpr int nt = K / BK;
    unsigned voffB[2], vA[2][2], vN[2][2];
#pragma unroll
    for (int i = 0; i < 2; ++i) { int R, C; stage_rc(tid * 16 + i * 8192, R, C); const int Rb = Epi::PERM ? ((R & ~31) + perm32(R & 31)) : R;
        voffB[i] = (unsigned)(Rb * K + C) * 2u;
        vA[0][i] = (unsigned)(R * K + C) * 2u; vA[1][i] = vA[0][i]; vN[0][i] = vA[0][i]; vN[1][i] = vA[0][i]; }
    constexpr size_t hA = GATHER ? (size_t)0 : (size_t)HALF * K * 2;
    constexpr size_t kstep = (size_t)(BK * 2);
    constexpr size_t hstep = (size_t)HALF * K * 2;
    const unsigned ldsw = (unsigned)wid * 1024u;
    const int aoff = lds_byte(wr * 64 + fr, fq * 8), boff = lds_byte(wc * 32 + fr, fq * 8);
#define PG8_SA(b, h) (((b) * 2 + (h)) * HTB)
#define PG8_SB(b, h) ((4 + (b) * 2 + (h)) * HTB)
#define PG8_STAGE(bufoff, gbase, voff) do { _Pragma("unroll") for (int _i = 0; _i < 2; ++_i) \
        __builtin_amdgcn_global_load_lds((const unsigned*)((const char*)(gbase) + (voff)[_i]), (LAS unsigned*)(lds + (bufoff) + ldsw + _i * 8192), 16, 0, 0); } while (0)
#define PG8_LDA(dst, b, h) do { _Pragma("unroll") for (int m = 0; m < 4; ++m) _Pragma("unroll") for (int k = 0; k < 2; ++k) dst[m][k] = *(const LAS bf16x8*)(lds + PG8_SA(b, h) + aoff + m * 2048 + k * 1024); } while (0)
#define PG8_LDB(dst, b, h) do { _Pragma("unroll") for (int n = 0; n < 2; ++n) _Pragma("unroll") for (int k = 0; k < 2; ++k) dst[n][k] = *(const LAS bf16x8*)(lds + PG8_SB(b, h) + boff + n * 2048 + k * 1024); } while (0)
#define PG8_MMA(ai, bj, At, Bt) do { __builtin_amdgcn_s_setprio(1); _Pragma("unroll") for (int m = 0; m < 4; ++m) _Pragma("unroll") for (int n = 0; n < 2; ++n) _Pragma("unroll") for (int k = 0; k < 2; ++k) \
        acc[ai][bj][m][n] = __builtin_amdgcn_mfma_f32_16x16x32_bf16(Bt[n][k], At[m][k], acc[ai][bj][m][n], 0, 0, 0); __builtin_amdgcn_s_setprio(0); } while (0)
#define PG8_WAIT_V(n) asm volatile("s_waitcnt vmcnt(" #n ")" ::: "memory")
#define PG8_WAIT_L(n) asm volatile("s_waitcnt lgkmcnt(" #n ")" ::: "memory")
#define PG8_BAR __builtin_amdgcn_s_barrier()
#define PG8_SCHED __builtin_amdgcn_sched_barrier(0)
#define PG8_GVOFF(u, vo) do { _Pragma("unroll") for (int _h = 0; _h < 2; ++_h) _Pragma("unroll") for (int _i = 0; _i < 2; ++_i) { int _R, _C; stage_rc(tid * 16 + _i * 8192, _R, _C); \
        const int _idx = _h * HALF + _R; const int _tok = (_idx < (u).nvalid) ? (u).list[_idx] : 0; vo[_h][_i] = (unsigned)(_tok * K + _C) * 2u; } } while (0)
    Unit cur, nxt; int ui = 0;
    if (!S.next(0, cur)) return;
    if constexpr (GATHER) { PG8_GVOFF(cur, vA); }
    Acc acc;
#pragma unroll
    for (int a = 0; a < 2; ++a)
#pragma unroll
        for (int b = 0; b < 2; ++b)
#pragma unroll
            for (int m = 0; m < 4; ++m)
#pragma unroll
                for (int n = 0; n < 2; ++n) acc[a][b][m][n] = (f32x4){0.f, 0.f, 0.f, 0.f};
    bf16x8 At[4][2], B0[2][2], B1[2][2];
    const char* cA = cur.a; const char* cB = cur.b;
    PG8_STAGE(PG8_SB(0, 0), cB, voffB); PG8_STAGE(PG8_SB(0, 1), cB + hstep, voffB); PG8_STAGE(PG8_SA(0, 0), cA, vA[0]); PG8_STAGE(PG8_SA(0, 1), cA + hA, vA[GATHER ? 1 : 0]);
    if (wr == 1) PG8_BAR;
    PG8_WAIT_V(2); PG8_BAR;
    PG8_STAGE(PG8_SB(1, 0), cB + kstep, voffB); PG8_STAGE(PG8_SA(1, 0), cA + kstep, vA[0]); PG8_STAGE(PG8_SB(1, 1), cB + hstep + kstep, voffB);
    PG8_WAIT_V(6); PG8_BAR;
    for (;;) {
        const bool has_next = S.next(ui + 1, nxt);
        if constexpr (GATHER) { if (has_next) { PG8_GVOFF(nxt, vN); } }
        const char* nA = has_next ? nxt.a : cA; const char* nB = has_next ? nxt.b : cB;
        for (int t = 0; t < nt; t += 2) {
            const bool last = (t == nt - 2);
            const char* a1 = cA + (size_t)(t + 1) * kstep;
            const char* a2 = last ? nA : cA + (size_t)(t + 2) * kstep; const char* b2 = last ? nB : cB + (size_t)(t + 2) * kstep;
            const char* a3 = a2 + kstep; const char* b3 = b2 + kstep;
            unsigned v2[2][2];
#pragma unroll
            for (int h = 0; h < 2; ++h)
#pragma unroll
                for (int i = 0; i < 2; ++i) v2[h][i] = (GATHER && last) ? vN[h][i] : vA[GATHER ? h : 0][i];
            PG8_LDB(B0, 0, 0); PG8_LDB(B1, 0, 1); PG8_SCHED; PG8_LDA(At, 0, 0); PG8_STAGE(PG8_SA(1, 1), a1 + hA, vA[GATHER ? 1 : 0]);
            PG8_WAIT_V(8); PG8_WAIT_L(0); PG8_BAR; PG8_MMA(0, 0, At, B0); PG8_MMA(0, 1, At, B1); PG8_BAR; PG8_SCHED;
            PG8_LDA(At, 0, 1); PG8_STAGE(PG8_SB(0, 0), b2, voffB); PG8_STAGE(PG8_SB(0, 1), b2 + hstep, voffB); PG8_STAGE(PG8_SA(0, 0), a2, v2[0]);
            PG8_WAIT_V(8); PG8_WAIT_L(0); PG8_BAR; PG8_MMA(1, 0, At, B0); PG8_MMA(1, 1, At, B1); PG8_BAR; PG8_SCHED;
            PG8_LDB(B0, 1, 0); PG8_LDB(B1, 1, 1); PG8_SCHED; PG8_LDA(At, 1, 0); PG8_STAGE(PG8_SA(0, 1), a2 + hA, v2[1]);
            PG8_WAIT_V(8); PG8_WAIT_L(0); PG8_BAR; PG8_MMA(0, 0, At, B0); PG8_MMA(0, 1, At, B1); PG8_BAR; PG8_SCHED;
            PG8_LDA(At, 1, 1); PG8_STAGE(PG8_SB(1, 0), b3, voffB); PG8_STAGE(PG8_SB(1, 1), b3 + hstep, voffB); PG8_STAGE(PG8_SA(1, 0), a3, v2[0]);
            PG8_WAIT_V(8); PG8_WAIT_L(0); PG8_BAR; PG8_MMA(1, 0, At, B0); PG8_MMA(1, 1, At, B1); PG8_BAR; PG8_SCHED;
        }
        if (wr == 0) PG8_BAR;
        E(acc, cur, wr, wc, fr, fq);
        if (!has_next) break;
#pragma unroll
        for (int a = 0; a < 2; ++a)
#pragma unroll
            for (int b = 0; b < 2; ++b)
#pragma unroll
                for (int m = 0; m < 4; ++m)
#pragma unroll
                    for (int n = 0; n < 2; ++n) acc[a][b][m][n] = (f32x4){0.f, 0.f, 0.f, 0.f};
        cur = nxt; cA = nA; cB = nB; ++ui;
        if constexpr (GATHER) {
#pragma unroll
            for (int h = 0; h < 2; ++h)
#pragma unroll
                for (int i = 0; i < 2; ++i) vA[h][i] = vN[h][i];
        }
        if (wr == 1) PG8_BAR;
    }
    PG8_WAIT_V(0);
    PG8_BAR;
#undef PG8_SA
#undef PG8_SB
#undef PG8_STAGE
#undef PG8_LDA
#undef PG8_LDB
#undef PG8_MMA
#undef PG8_WAIT_V
#undef PG8_WAIT_L
#undef PG8_BAR
#undef PG8_SCHED
#undef PG8_GVOFF
}

struct EpiProj {
    static constexpr bool PERM = true;
    bf16_t* O; const LAS float* gtab;
    __device__ __forceinline__ void operator()(const Acc& acc, const Unit& u, int wr, int wc, int fr, int fq) const {
        const int mode = u.mode;
        f32x4 g[2][2];
#pragma unroll
        for (int bj = 0; bj < 2; ++bj)
#pragma unroll
            for (int n = 0; n < 2; ++n) g[bj][n] = (mode == 1 || mode == 2) ? *(const LAS f32x4*)(gtab + (mode - 1) * 64 + 32 * bj + 8 * fq + 4 * n) : (f32x4){1.f, 1.f, 1.f, 1.f};
        const float sc = (mode == 3) ? C2 : 1.f;
#pragma unroll
        for (int ai = 0; ai < 2; ++ai)
#pragma unroll
            for (int m = 0; m < 4; ++m) {
                const int row = u.row0 + ai * HALF + wr * 64 + m * 16 + fr;
                float rs = sc;
                if (mode == 1 || mode == 2) {
                    float ss = 0.f;
#pragma unroll
                    for (int bj = 0; bj < 2; ++bj)
#pragma unroll
                        for (int n = 0; n < 2; ++n) { const f32x4 v = acc[ai][bj][m][n]; ss += (v[0] * v[0] + v[1] * v[1]) + (v[2] * v[2] + v[3] * v[3]); }
                    ss += xor_swz<16>(ss); ss = xor32_sum(ss);
                    rs = __builtin_amdgcn_rsqf(ss * (1.f / 64.f) + EPS);
                }
                bf16_t* rowp = O + (size_t)row * NQKV + u.col0 + 64 * wc + 8 * fq;
#pragma unroll
                for (int bj = 0; bj < 2; ++bj) {
                    const f32x4 v0 = acc[ai][bj][m][0] * rs * g[bj][0], v1 = acc[ai][bj][m][1] * rs * g[bj][1];
                    u32x4 w; w.x = cvt_pk_bf16(v0[0], v0[1]); w.y = cvt_pk_bf16(v0[2], v0[3]); w.z = cvt_pk_bf16(v1[0], v1[1]); w.w = cvt_pk_bf16(v1[2], v1[3]);
                    *(u32x4*)(rowp + 32 * bj) = w;
                }
            }
    }
};
struct EpiResid {
    static constexpr bool PERM = false;
    float* X;
    __device__ __forceinline__ void operator()(const Acc& acc, const Unit& u, int wr, int wc, int fr, int fq) const {
#pragma unroll
        for (int ai = 0; ai < 2; ++ai)
#pragma unroll
            for (int m = 0; m < 4; ++m) {
                float* rowp = X + (size_t)(u.row0 + ai * HALF + wr * 64 + m * 16 + fr) * DM + u.col0 + wc * 32 + 4 * fq;
#pragma unroll
                for (int bj = 0; bj < 2; ++bj)
#pragma unroll
                    for (int n = 0; n < 2; ++n) { f32x4* p = (f32x4*)(rowp + bj * HALF + n * 16); *p = *p + acc[ai][bj][m][n]; }
                if (m & 1) asm volatile("" ::: "memory");
            }
    }
};
struct EpiSwiGLU {
    static constexpr bool PERM = true;
    bf16_t* Hb;
    __device__ __forceinline__ void operator()(const Acc& acc, const Unit& u, int wr, int wc, int fr, int fq) const {
#pragma unroll
        for (int ai = 0; ai < 2; ++ai)
#pragma unroll
            for (int m = 0; m < 4; ++m) {
                bf16_t* rowp = Hb + (size_t)(u.row0 + ai * HALF + wr * 64 + m * 16 + fr) * DM + u.col0 + wc * 32 + 8 * fq;
                float r[8];
#pragma unroll
                for (int n = 0; n < 2; ++n)
#pragma unroll
                    for (int i = 0; i < 4; ++i) { const float gt = acc[ai][0][m][n][i], up = acc[ai][1][m][n][i];
                        r[4 * n + i] = gt * __builtin_amdgcn_rcpf(1.f + __builtin_amdgcn_exp2f(-gt * LOG2E)) * up; }
                u32x4 w; w.x = cvt_pk_bf16(r[0], r[1]); w.y = cvt_pk_bf16(r[2], r[3]); w.z = cvt_pk_bf16(r[4], r[5]); w.w = cvt_pk_bf16(r[6], r[7]);
                *(u32x4*)rowp = w;
            }
    }
};
struct EpiBf16 {
    static constexpr bool PERM = true;
    bf16_t* Yb;
    __device__ __forceinline__ void operator()(const Acc& acc, const Unit& u, int wr, int wc, int fr, int fq) const {
#pragma unroll
        for (int ai = 0; ai < 2; ++ai)
#pragma unroll
            for (int m = 0; m < 4; ++m) {
                bf16_t* rowp = Yb + (size_t)(u.row0 + ai * HALF + wr * 64 + m * 16 + fr) * DM + u.col0 + wc * 32 + 8 * fq;
#pragma unroll
                for (int bj = 0; bj < 2; ++bj) { const f32x4 v0 = acc[ai][bj][m][0], v1 = acc[ai][bj][m][1];
                    u32x4 w; w.x = cvt_pk_bf16(v0[0], v0[1]); w.y = cvt_pk_bf16(v0[2], v0[3]); w.z = cvt_pk_bf16(v1[0], v1[1]); w.w = cvt_pk_bf16(v1[2], v1[3]);
                    *(u32x4*)(rowp + bj * HALF) = w; }
            }
    }
};

struct ProjSched {
    StaticOrder so; const char* A; const char* W; int mq, mk, s_lo, s_hi;
    __device__ bool next(int i, Unit& u) const { int pm, pn; if (!so.next(i, pm, pn)) return false;
        u.a = A + (size_t)pm * BM * K * 2; u.b = W + (size_t)pn * BM * K * 2; u.list = nullptr; u.nvalid = 0; u.row0 = pm * BM; u.col0 = pn * BM;
        u.mode = pn < mq ? 1 : (pn < mk ? 2 : ((pn >= s_lo && pn < s_hi) ? 3 : 0)); return true; }
};
struct WoutSched {
    StaticOrder so; const char* A; const char* W;
    __device__ bool next(int i, Unit& u) const { int pm, pn; if (!so.next(i, pm, pn)) return false;
        u.a = A + (size_t)pm * BM * K * 2; u.b = W + (size_t)pn * BM * K * 2; u.list = nullptr; u.nvalid = 0; u.row0 = pm * BM; u.col0 = pn * BM; u.mode = 0; return true; }
};
template <int NT, bool UP> struct MoeSched {
    const LAS int* tab;
    int G, c; const char* A; const char* W; const int* lists;
    __device__ bool next(int i, Unit& u) const {
        const int total = tab[16];
        const long L = (long)i * G + c; if (L >= (long)total * NT) return false;
        const int rt = (int)(L / NT), pn = (int)(L % NT);
        int e = 0;
#pragma unroll
        for (int j = 1; j < 16; ++j) e += (rt >= tab[j]) ? 1 : 0;
        e = __builtin_amdgcn_readfirstlane(e);
        const int r0 = __builtin_amdgcn_readfirstlane(tab[e]), ce = __builtin_amdgcn_readfirstlane(tab[17 + e]);
        const int rel0 = (rt - r0) * BM;
        if (UP) { u.a = A; u.b = W + ((size_t)e * 2048 + (size_t)pn * BM) * K * 2; u.list = lists + e * LISTCAP + rel0; u.nvalid = ce - rel0; u.col0 = pn * 128; }
        else    { u.a = A + (size_t)rt * BM * K * 2; u.b = W + ((size_t)e * 1024 + (size_t)pn * BM) * K * 2; u.list = nullptr; u.nvalid = 0; u.col0 = pn * BM; }
        u.row0 = rt * BM; u.mode = 0; return true;
    }
};
}

namespace att {
using bf16 = __hip_bfloat16;
constexpr int NW = 8, QBLK = 32, QB = QBLK * NW, KVBLK = 64;
constexpr int NSLOT = 3, SLOTB = 8192;
constexpr int LDS_K = 0, LDS_V = NSLOT * SLOTB, LDS_WS = 2 * NSLOT * SLOTB, LDS_OST = LDS_WS + NW * 64 * 4, LDS_END = LDS_OST + NW * 4096;
constexpr int LDS_FTAB = 86016;
static_assert(LDS_END <= LDS_FTAB && LDS_FTAB + 32768 <= RING_BYTES, "attention LDS map");
__device__ __forceinline__ int crow(int r, int hi) { return (r & 3) + 8 * (r >> 2) + 4 * hi; }
#define SBAR() __builtin_amdgcn_sched_barrier(0)
__device__ __forceinline__ void glds16(const void* gsrc, unsigned lds_dst) { unsigned keep;
  asm volatile("s_mov_b32 %0, m0\n\ts_mov_b32 m0, %2\n\ts_nop 0\n\tglobal_load_lds_dwordx4 %1, off\n\ts_mov_b32 m0, %0" : "=&s"(keep) : "v"(gsrc), "s"(lds_dst) : "memory"); }
typedef __bf16 bf16x2_t __attribute__((ext_vector_type(2)));
__device__ __forceinline__ unsigned cvtpk_s(float lo, float hi) { f32x2 v = {lo, hi}; bf16x2_t b = __builtin_convertvector(v, bf16x2_t); return __builtin_bit_cast(unsigned, b); }
#define WAIT_BAR(N) asm volatile("s_waitcnt vmcnt(" #N ") lgkmcnt(0)\n\ts_barrier" ::: "memory")
typedef LAS const char* lds_cptr;
typedef short v4i16_t __attribute__((ext_vector_type(4)));

__device__ __forceinline__ void qkt_acc(f32x16& p0, f32x16& p1, const char* Kslot, const bf16x8* qr, int r32, int hi) {
  const char* kb = Kslot + hi * 1024 + r32 * 16;
#pragma unroll
  for (int d0 = 0; d0 < 4; ++d0) {
    const bf16x8 b0 = *reinterpret_cast<const bf16x8*>(kb + d0 * 2048);
    const bf16x8 b1 = *reinterpret_cast<const bf16x8*>(kb + d0 * 2048 + 512);
    p0 = __builtin_amdgcn_mfma_f32_32x32x16_bf16(b0, qr[d0], p0, 0, 0, 0); p1 = __builtin_amdgcn_mfma_f32_32x32x16_bf16(b1, qr[d0], p1, 0, 0, 0); }
}
__device__ __forceinline__ void kload8(bf16x8* kf, lds_cptr kp) {
  kf[0] = *(const LAS bf16x8*)(kp);        kf[1] = *(const LAS bf16x8*)(kp + 512);
  kf[2] = *(const LAS bf16x8*)(kp + 2048); kf[3] = *(const LAS bf16x8*)(kp + 2560);
  kf[4] = *(const LAS bf16x8*)(kp + 4096); kf[5] = *(const LAS bf16x8*)(kp + 4608);
  kf[6] = *(const LAS bf16x8*)(kp + 6144); kf[7] = *(const LAS bf16x8*)(kp + 6656);
}
__device__ __forceinline__ void kload2(bf16x8* kf, lds_cptr kp, int j) { kf[2 * j] = *(const LAS bf16x8*)(kp + j * 2048); kf[2 * j + 1] = *(const LAS bf16x8*)(kp + j * 2048 + 512); }
__device__ __forceinline__ s16x4 vtr(lds_cptr p) { return __builtin_bit_cast(s16x4, __builtin_amdgcn_ds_read_tr16_b64_v4i16((LAS v4i16_t*)p)); }
__device__ __forceinline__ void pv(f32x16* o, int vb, bf16x8 pa0, bf16x8 pa1, bf16x8 pa2, bf16x8 pa3) {
#pragma unroll
  for (int d0 = 0; d0 < 2; ++d0) { s16x4 lo[4], hi[4];
#pragma unroll
    for (int ks = 0; ks < 4; ++ks) {
      asm volatile("ds_read_b64_tr_b16 %0,%1 offset:%c2" : "=&v"(lo[ks]) : "v"(vb), "i"(d0 * 4096 + ks * 1024) : "memory");
      asm volatile("ds_read_b64_tr_b16 %0,%1 offset:%c2" : "=&v"(hi[ks]) : "v"(vb), "i"(d0 * 4096 + ks * 1024 + 512) : "memory"); }
    asm volatile("s_waitcnt lgkmcnt(0)" ::: "memory"); SBAR();
#define PK(k) (bf16x8){lo[k][0], lo[k][1], lo[k][2], lo[k][3], hi[k][0], hi[k][1], hi[k][2], hi[k][3]}
    o[d0] = __builtin_amdgcn_mfma_f32_32x32x16_bf16(pa0, PK(0), o[d0], 0, 0, 0);
    o[d0] = __builtin_amdgcn_mfma_f32_32x32x16_bf16(pa1, PK(1), o[d0], 0, 0, 0);
    o[d0] = __builtin_amdgcn_mfma_f32_32x32x16_bf16(pa2, PK(2), o[d0], 0, 0, 0);
    o[d0] = __builtin_amdgcn_mfma_f32_32x32x16_bf16(pa3, PK(3), o[d0], 0, 0, 0);
#undef PK
  }
}
template <int PO> __device__ __forceinline__ void store_o(const f32x16* o, const float* rs, bf16* Ow, char* shm, int wid, int lane, int r32, int hi) {
  bf16* stg = (bf16*)(shm + LDS_OST) + wid * 2048;
#pragma unroll
  for (int r = 0; r < 16; ++r) { const int orow = crow(r, hi);
#pragma unroll
    for (int d0 = 0; d0 < 2; ++d0) stg[orow * 64 + d0 * 32 + r32] = __float2bfloat16(o[d0][r] * rs[r]); }
  asm volatile("s_waitcnt lgkmcnt(0)" ::: "memory");
#pragma unroll
  for (int i = 0; i < 4; ++i) { const int row = i * 8 + (lane >> 3), ch = lane & 7; const u32x4 v = *(const u32x4*)(stg + row * 64 + ch * 8); *(u32x4*)(Ow + (long)row * PO + ch * 8) = v; }
}

template <int PO> __device__ __forceinline__ void attn_unit_b(int qb, int js, const bf16* Qh, const bf16* __restrict__ Kh, const bf16* __restrict__ Vh, bf16* Oh, float Bp, char* shm, const int tid) {
  const int lane = tid & 63, r32 = lane & 31, hi = lane >> 5; const int wid = __builtin_amdgcn_readfirstlane(tid >> 6);
  const int q0 = qb * QB;
  const bf16* Qw = Qh + (long)(q0 + wid * QBLK) * PQ;
  const unsigned lds0 = (unsigned)(uintptr_t)shm;
  float* wsf = (float*)(shm + LDS_WS) + wid * 64;
  const bf16* ksrc = Kh + (long)(js * KVBLK + lane) * PQ + wid * 8;
  const bf16* vsrc = Vh + (long)(js * KVBLK + 16 * (wid & 3) + (lane >> 2)) * PQ + (wid >> 2) * 32 + (lane & 3) * 8;
  const unsigned kdst = lds0 + LDS_K + wid * 1024, vdst = lds0 + LDS_V + wid * 1024;
#define DMA_K(t, slot) glds16(ksrc + (long)(t) * KVBLK * PQ, (unsigned)__builtin_amdgcn_readfirstlane(kdst + (slot)))
#define DMA_V(t, slot) glds16(vsrc + (long)(t) * KVBLK * PQ, (unsigned)__builtin_amdgcn_readfirstlane(vdst + (slot)))
  const int vb0 = (int)(lds0 + LDS_V) + ((lane >> 4) & 1) * 32 + (lane & 3) * 8 + (4 * hi + ((lane & 15) >> 2)) * 64;
  const char* Kbase = shm + LDS_K; bf16x8 kf[8];
  const lds_cptr shm3 = (lds_cptr)shm; const lds_cptr kp0 = shm3 + LDS_K + hi * 1024 + r32 * 16; const lds_cptr vp0 = shm3 + LDS_V + ((lane >> 4) & 1) * 32 + (lane & 3) * 8 + (4 * hi + ((lane & 15) >> 2)) * 64;
  const LAS float* ftab = (const LAS float*)(shm3 + LDS_FTAB);
  const int NT = (q0 + QB) / KVBLK - js;
  DMA_K(0, 0); DMA_V(0, 0); DMA_K(1, SLOTB);
  bf16x8 qr[4];
#pragma unroll
  for (int d0 = 0; d0 < 4; ++d0) qr[d0] = *reinterpret_cast<const bf16x8*>(&Qw[(long)r32 * PQ + d0 * 16 + hi * 8]);
  float l_reg = 0.f; f32x16 o[2]; o[0] = f32x16{}; o[1] = f32x16{};
  const int qrel = wid * QBLK + r32;
  const float rc = ftab[q0 + qrel] - Bp;
  const LAS float* fth = ftab + 64 * js + 4 * hi;
#define CMASK(P0, P1, t) do { const int jb_ = (t) - (NT - 4); if (jb_ >= 0) { const int kb_ = 64 * jb_ + 4 * hi; \
    _Pragma("unroll") for (int r = 0; r < 16; ++r) { const int kv_ = kb_ + (r & 3) + 8 * (r >> 2); if (kv_ > qrel) P0[r] = -INFINITY; if (kv_ + 32 > qrel) P1[r] = -INFINITY; } } } while (0)
#define BIASG(P, t, ph, g) do { const f32x4 f_ = *(const LAS f32x4*)(fth + 64 * (t) + 32 * (ph) + 8 * (g)); \
    P[4 * (g)] = rc - f_[0]; P[4 * (g) + 1] = rc - f_[1]; P[4 * (g) + 2] = rc - f_[2]; P[4 * (g) + 3] = rc - f_[3]; } while (0)
#define BIAS_FULL(P0, P1, t) do { BIASG(P0, t, 0, 0); BIASG(P0, t, 0, 1); BIASG(P0, t, 0, 2); BIASG(P0, t, 0, 3); BIASG(P1, t, 1, 0); BIASG(P1, t, 1, 1); BIASG(P1, t, 1, 2); BIASG(P1, t, 1, 3); } while (0)
  f32x16 rcv;
#pragma unroll
  for (int r = 0; r < 16; ++r) rcv[r] = rc;
  asm volatile("" : "+v"(rcv));
  f32x16 pA0, pA1, pB0, pB1;
  BIAS_FULL(pA0, pA1, 0);
  int sl_prev = 0, sl_cur = 0, sl_next = SLOTB;
#define ROT() do { sl_prev = sl_cur; sl_cur = sl_next; sl_next = (sl_next == (NSLOT - 1) * SLOTB) ? 0 : sl_next + SLOTB; } while (0)
  DMA_K(2, 2 * SLOTB);
  WAIT_BAR(3);
  qkt_acc(pA0, pA1, Kbase, qr, r32, hi); CMASK(pA0, pA1, 0);
#pragma unroll
  for (int r = 0; r < 16; ++r) { pA0[r] = __builtin_amdgcn_exp2f(pA0[r]); pA1[r] = __builtin_amdgcn_exp2f(pA1[r]); }
  WAIT_BAR(0);
  DMA_K(3, 0); DMA_V(1, SLOTB);
  ROT();
  kload8(kf, kp0 + sl_cur);
  WAIT_BAR(2);
  s16x4 vlo[8], vhi[8]; u32x4 pw0, pw1, pw2, pw3;
#define PKW(P, B) cvtpk_s(P[B], P[B + 1])
#define PAF(k) __builtin_bit_cast(bf16x8, pw##k)
#define VFR(i) (bf16x8){vlo[i][0], vlo[i][1], vlo[i][2], vlo[i][3], vhi[i][0], vhi[i][1], vhi[i][2], vhi[i][3]}
#define PIN(x) asm volatile("" : "+v"(x))
#define GAPA(MF, A0, A1, A2, A3, W0, W1, PW) do { MF; sacc += A0; sacc += A1; sacc += A2; sacc += A3; PIN(sacc); W0; W1; PIN(PW); SBAR(); } while (0)
#define EX(v) __builtin_amdgcn_exp2f(v)
#define GAPB(MF, X, B) do { MF; X[B] = EX(X[B]); X[B + 1] = EX(X[B + 1]); X[B + 2] = EX(X[B + 2]); X[B + 3] = EX(X[B + 3]); PIN(X); SBAR(); } while (0)
#define FLD(P, t, ph, g) do { const f32x4 f_ = *(const LAS f32x4*)(fth + 64 * (t) + 32 * (ph) + 8 * (g)); P[4 * (g)] = f_[0]; P[4 * (g) + 1] = f_[1]; P[4 * (g) + 2] = f_[2]; P[4 * (g) + 3] = f_[3]; } while (0)
#define VRD(i) do { vlo[i] = vtr(vp_ + (((i) >> 2) * 4096 + ((i) & 3) * 1024)); vhi[i] = vtr(vp_ + (((i) >> 2) * 4096 + ((i) & 3) * 1024 + 512)); } while (0)
#define KRD(G, j) do { if (G) { kload2(kf, kp0 + sl_next, j); SBAR(); } } while (0)
#define MF32(a, b, c) __builtin_amdgcn_mfma_f32_32x32x16_bf16(a, b, c, 0, 0, 0)
#define STEP(C0, C1, P0, P1, t, GK, GV, GL) do { SBAR(); \
    const lds_cptr vp_ = vp0 + sl_prev; \
    VRD(0); SBAR(); float sacc = (P0[0] + P0[1]); \
    GAPA(C0 = MF32(kf[0], qr[0], rcv), P0[2], P0[3], P0[4], P0[5],     pw0[0] = PKW(P0, 0), pw0[1] = PKW(P0, 2), pw0); \
    VRD(4); SBAR(); GAPA(C1 = MF32(kf[1], qr[0], rcv), P0[6], P0[7], P0[8], P0[9],     pw0[2] = PKW(P0, 4), pw0[3] = PKW(P0, 6), pw0); \
    VRD(1); SBAR(); GAPA(C0 = MF32(kf[2], qr[1], C0), P0[10], P0[11], P0[12], P0[13], pw1[0] = PKW(P0, 8), pw1[1] = PKW(P0, 10), pw1); \
    VRD(5); SBAR(); GAPA(C1 = MF32(kf[3], qr[1], C1), P0[14], P0[15], P1[0], P1[1],   pw1[2] = PKW(P0, 12), pw1[3] = PKW(P0, 14), pw1); \
    VRD(2); FLD(P0, t, 0, 0); SBAR(); GAPA(C0 = MF32(kf[4], qr[2], C0), P1[2], P1[3], P1[4], P1[5],     pw2[0] = PKW(P1, 0), pw2[1] = PKW(P1, 2), pw2); \
    VRD(6); FLD(P0, t, 0, 1); SBAR(); GAPA(C1 = MF32(kf[5], qr[2], C1), P1[6], P1[7], P1[8], P1[9],     pw2[2] = PKW(P1, 4), pw2[3] = PKW(P1, 6), pw2); \
    VRD(3); FLD(P0, t, 0, 2); SBAR(); GAPA(C0 = MF32(kf[6], qr[3], C0), P1[10], P1[11], P1[12], P1[13], pw3[0] = PKW(P1, 8), pw3[1] = PKW(P1, 10), pw3); \
    VRD(7); FLD(P0, t, 0, 3); SBAR(); GAPA(C1 = MF32(kf[7], qr[3], C1), P1[14], P1[15], 0.f, 0.f,       pw3[2] = PKW(P1, 12), pw3[3] = PKW(P1, 14), pw3); \
    l_reg += sacc; \
    if (GK) { DMA_K((t) + 3, sl_cur); } if (GV) { DMA_V((t) + 1, sl_next); } \
    FLD(P1, t, 1, 0); FLD(P1, t, 1, 1); FLD(P1, t, 1, 2); FLD(P1, t, 1, 3); \
    _Pragma("unroll") for (int r = 0; r < 16; ++r) C0[r] -= P0[r]; \
    _Pragma("unroll") for (int r = 0; r < 16; ++r) C1[r] -= P1[r]; \
    CMASK(C0, C1, t); \
    SBAR(); \
    GAPB(o[0] = MF32(PAF(0), VFR(0), o[0]), C0, 0); \
    GAPB(o[1] = MF32(PAF(0), VFR(4), o[1]), C0, 4); \
    KRD(GL, 0); GAPB(o[0] = MF32(PAF(1), VFR(1), o[0]), C0, 8); \
    KRD(GL, 1); GAPB(o[1] = MF32(PAF(1), VFR(5), o[1]), C0, 12); \
    KRD(GL, 2); GAPB(o[0] = MF32(PAF(2), VFR(2), o[0]), C1, 0); \
    KRD(GL, 3); GAPB(o[1] = MF32(PAF(2), VFR(6), o[1]), C1, 4); \
    GAPB(o[0] = MF32(PAF(3), VFR(3), o[0]), C1, 8); \
    GAPB(o[1] = MF32(PAF(3), VFR(7), o[1]), C1, 12); \
    } while (0)
  int t = 1;
#undef CMASK
#define CMASK(P0, P1, t) do { } while (0)
  for (; t + 5 < NT; t += 2) {
    STEP(pB0, pB1, pA0, pA1, t, true, true, true);     WAIT_BAR(2); ROT();
    STEP(pA0, pA1, pB0, pB1, t + 1, true, true, true); WAIT_BAR(2); ROT();
  }
#undef CMASK
#define CMASK(P0, P1, t) do { const int jb_ = (t) - (NT - 4); if (jb_ >= 0) { const int kb_ = 64 * jb_ + 4 * hi; \
    _Pragma("unroll") for (int r = 0; r < 16; ++r) { const int kv_ = kb_ + (r & 3) + 8 * (r >> 2); if (kv_ > qrel) P0[r] = -INFINITY; if (kv_ + 32 > qrel) P1[r] = -INFINITY; } } } while (0)
#define ENDW(tt) do { if ((tt) + 3 < NT) { WAIT_BAR(2); } else if ((tt) + 2 < NT) { WAIT_BAR(1); } else { WAIT_BAR(0); } } while (0)
  for (; t + 1 < NT; t += 2) {
    STEP(pB0, pB1, pA0, pA1, t, (t + 3 < NT), (t + 1 < NT), (t + 1 < NT));         ENDW(t);     ROT();
    STEP(pA0, pA1, pB0, pB1, t + 1, (t + 4 < NT), (t + 2 < NT), (t + 2 < NT));     ENDW(t + 1); ROT();
  }
  STEP(pB0, pB1, pA0, pA1, NT - 1, false, false, false);
  { float sacc = pB0[0] + pB0[1];
#pragma unroll
    for (int r = 2; r < 16; ++r) sacc += pB0[r];
#pragma unroll
    for (int r = 0; r < 16; ++r) sacc += pB1[r];
    l_reg += sacc;
    pw0 = (u32x4){PKW(pB0, 0), PKW(pB0, 2), PKW(pB0, 4), PKW(pB0, 6)}; pw1 = (u32x4){PKW(pB0, 8), PKW(pB0, 10), PKW(pB0, 12), PKW(pB0, 14)};
    pw2 = (u32x4){PKW(pB1, 0), PKW(pB1, 2), PKW(pB1, 4), PKW(pB1, 6)}; pw3 = (u32x4){PKW(pB1, 8), PKW(pB1, 10), PKW(pB1, 12), PKW(pB1, 14)};
    SBAR(); pv(o, vb0 + sl_cur, PAF(0), PAF(1), PAF(2), PAF(3)); }
#undef PKW
#undef PAF
#undef VFR
#undef PIN
#undef GAPA
#undef GAPB
#undef FLD
#undef EX
#undef VRD
#undef KRD
#undef STEP
#undef ENDW
#undef MF32
  { auto rr = __builtin_amdgcn_permlane32_swap(__float_as_uint(l_reg), __float_as_uint(l_reg), false, false); l_reg = __uint_as_float(rr[0]) + __uint_as_float(rr[1]); }
  if (hi == 0) wsf[32 + r32] = l_reg; asm volatile("s_waitcnt lgkmcnt(0)" ::: "memory");
  float rli[16];
#pragma unroll
  for (int r = 0; r < 16; ++r) rli[r] = __builtin_amdgcn_rcpf(wsf[32 + crow(r, hi)]);
  store_o<PO>(o, rli, Oh + (long)(q0 + wid * QBLK) * PO, shm, wid, lane, r32, hi);
  asm volatile("s_waitcnt lgkmcnt(0)\n\ts_barrier" ::: "memory");
#undef DMA_K
#undef DMA_V
#undef CMASK
#undef BIASG
#undef BIAS_FULL
#undef ROT
}

template <int PO> __device__ __forceinline__ void sb_unit(int qb, const bf16* Qh, const bf16* __restrict__ Kh, const bf16* __restrict__ Vh, bf16* Oh, char* shm, const int tid) {
  const int lane = tid & 63, r32 = lane & 31, hi = lane >> 5; const int wid = __builtin_amdgcn_readfirstlane(tid >> 6);
  const int q0 = qb * QB;
  const bf16* Qw = Qh + (long)(q0 + wid * QBLK) * PQ;
  const unsigned lds0 = (unsigned)(uintptr_t)shm;
  const bf16* ksrc = Kh + (long)lane * PQ + wid * 8;
  const bf16* vsrc = Vh + (long)(16 * (wid & 3) + (lane >> 2)) * PQ + (wid >> 2) * 32 + (lane & 3) * 8;
  const unsigned kdst = lds0 + LDS_K + wid * 1024, vdst = lds0 + LDS_V + wid * 1024;
#define DMA_K(t, slot) glds16(ksrc + (long)(t) * KVBLK * PQ, (unsigned)__builtin_amdgcn_readfirstlane(kdst + (slot)))
#define DMA_V(t, slot) glds16(vsrc + (long)(t) * KVBLK * PQ, (unsigned)__builtin_amdgcn_readfirstlane(vdst + (slot)))
  const int vb0 = (int)(lds0 + LDS_V) + ((lane >> 4) & 1) * 32 + (lane & 3) * 8 + (4 * hi + ((lane & 15) >> 2)) * 64;
  volatile LAS unsigned* flags = (volatile LAS unsigned*)((LAS char*)shm + LDS_WS);
  bf16x8 qr[4];
#pragma unroll
  for (int d0 = 0; d0 < 4; ++d0) qr[d0] = *reinterpret_cast<const bf16x8*>(&Qw[(long)r32 * PQ + d0 * 16 + hi * 8]);
  f32x16 o[2]; o[0] = f32x16{}; o[1] = f32x16{};
  const int qrel = wid * QBLK + r32;
  float arun = 0.f;
  const int jt = 4 * qb + 3;
  DMA_K(jt, 0); DMA_V(jt, 0);
  int slot = 0;
  for (int it = 0;; ++it) {
    const int tile = jt - it;
    const bool has_next = tile > 0;
    if (has_next) { DMA_K(tile - 1, (slot ^ 1) * SLOTB); DMA_V(tile - 1, (slot ^ 1) * SLOTB); WAIT_BAR(2); } else { WAIT_BAR(0); }
    const int jb = tile - 4 * qb;
    const bool active = (jb < 0) || (64 * jb < 32 * wid + 31);
    if (active) {
      f32x16 z0 = f32x16{}, z1 = f32x16{};
      qkt_acc(z0, z1, shm + LDS_K + slot * SLOTB, qr, r32, hi);
      if (jb >= 0) { const int kb = 64 * jb + 4 * hi;
#pragma unroll
        for (int r = 0; r < 16; ++r) { const int kv = kb + (r & 3) + 8 * (r >> 2); if (kv >= qrel) z0[r] = -INFINITY; if (kv + 32 >= qrel) z1[r] = -INFINITY; } }
      f32x16 k0, k1;
#pragma unroll
      for (int r = 0; r < 16; ++r) {
        { const float z = z0[r]; const float e = __builtin_amdgcn_exp2f(-__builtin_fabsf(z)); k0[r] = -(fmaxf(z, 0.f) + __builtin_amdgcn_logf(1.f + e)); }
        { const float z = z1[r]; const float e = __builtin_amdgcn_exp2f(-__builtin_fabsf(z)); k1[r] = -(fmaxf(z, 0.f) + __builtin_amdgcn_logf(1.f + e)); } }
      float s[2][4], ps[2][4];
#pragma unroll
      for (int g = 0; g < 4; ++g) { s[0][g] = (k0[4 * g] + k0[4 * g + 1]) + (k0[4 * g + 2] + k0[4 * g + 3]); s[1][g] = (k1[4 * g] + k1[4 * g + 1]) + (k1[4 * g + 2] + k1[4 * g + 3]); }
#pragma unroll
      for (int p = 0; p < 2; ++p)
#pragma unroll
        for (int g = 0; g < 4; ++g) ps[p][g] = xor32_partner(s[p][g], hi != 0);
      float suf = 0.f;
      float T[2][4];
#pragma unroll
      for (int p = 1; p >= 0; --p)
#pragma unroll
        for (int g = 3; g >= 0; --g) { T[p][g] = arun + suf + (hi == 0 ? ps[p][g] : 0.f); suf += s[p][g] + ps[p][g]; }
#pragma unroll
      for (int g = 0; g < 4; ++g) {
        { const float a3 = T[0][g], a2 = a3 + k0[4 * g + 3], a1 = a2 + k0[4 * g + 2], a0 = a1 + k0[4 * g + 1];
          z0[4 * g + 3] = __builtin_amdgcn_exp2f(z0[4 * g + 3] + k0[4 * g + 3] + a3); z0[4 * g + 2] = __builtin_amdgcn_exp2f(z0[4 * g + 2] + k0[4 * g + 2] + a2);
          z0[4 * g + 1] = __builtin_amdgcn_exp2f(z0[4 * g + 1] + k0[4 * g + 1] + a1); z0[4 * g]     = __builtin_amdgcn_exp2f(z0[4 * g] + k0[4 * g] + a0); }
        { const float a3 = T[1][g], a2 = a3 + k1[4 * g + 3], a1 = a2 + k1[4 * g + 2], a0 = a1 + k1[4 * g + 1];
          z1[4 * g + 3] = __builtin_amdgcn_exp2f(z1[4 * g + 3] + k1[4 * g + 3] + a3); z1[4 * g + 2] = __builtin_amdgcn_exp2f(z1[4 * g + 2] + k1[4 * g + 2] + a2);
          z1[4 * g + 1] = __builtin_amdgcn_exp2f(z1[4 * g + 1] + k1[4 * g + 1] + a1); z1[4 * g]     = __builtin_amdgcn_exp2f(z1[4 * g] + k1[4 * g] + a0); } }
      arun += suf;
      u32x4 w0, w1, w2, w3;
      w0 = (u32x4){cvtpk_s(z0[0], z0[1]), cvtpk_s(z0[2], z0[3]), cvtpk_s(z0[4], z0[5]), cvtpk_s(z0[6], z0[7])};
      w1 = (u32x4){cvtpk_s(z0[8], z0[9]), cvtpk_s(z0[10], z0[11]), cvtpk_s(z0[12], z0[13]), cvtpk_s(z0[14], z0[15])};
      w2 = (u32x4){cvtpk_s(z1[0], z1[1]), cvtpk_s(z1[2], z1[3]), cvtpk_s(z1[4], z1[5]), cvtpk_s(z1[6], z1[7])};
      w3 = (u32x4){cvtpk_s(z1[8], z1[9]), cvtpk_s(z1[10], z1[11]), cvtpk_s(z1[12], z1[13]), cvtpk_s(z1[14], z1[15])};
      pv(o, vb0 + slot * SLOTB, __builtin_bit_cast(bf16x8, w0), __builtin_bit_cast(bf16x8, w1), __builtin_bit_cast(bf16x8, w2), __builtin_bit_cast(bf16x8, w3));
    }
    const bool done_w = __all(arun < -152.f);
    if (lane == 0) flags[wid] = done_w ? 1u : 0u;
    asm volatile("s_waitcnt lgkmcnt(0)\n\ts_barrier" ::: "memory");
    unsigned alld = 1u;
#pragma unroll
    for (int w = 0; w < NW; ++w) alld &= flags[w];
    alld = __builtin_amdgcn_readfirstlane(alld);
    if (!has_next || alld) break;
    slot ^= 1;
  }
  asm volatile("s_waitcnt vmcnt(0)" ::: "memory");
  float ones[16];
#pragma unroll
  for (int r = 0; r < 16; ++r) ones[r] = 1.f;
  store_o<PO>(o, ones, Oh + (long)(q0 + wid * QBLK) * PO, shm, wid, lane, r32, hi);
  asm volatile("s_waitcnt vmcnt(0) lgkmcnt(0)\n\ts_barrier" ::: "memory");
#undef DMA_K
#undef DMA_V
}
#undef SBAR
#undef WAIT_BAR
}

#define XB_TMO      128
#define XB_XCNT(j)  (256  + 64 * (j))
#define XB_XSUB(j)  (1280 + 64 * (j))
#define XB_XGEN(j)  (2304 + 64 * (j))
#define XB_TOP      3328
#define XB_TOPGEN   3392
#define XCD_BAR_WORDS 3456
#define XB_SPIN_CAP (1u << 18)
__device__ __forceinline__ unsigned xb_ld(unsigned* p)              { return __hip_atomic_load(p, __ATOMIC_RELAXED, __HIP_MEMORY_SCOPE_AGENT); }
__device__ __forceinline__ unsigned xb_add(unsigned* p, unsigned v) { return __hip_atomic_fetch_add(p, v, __ATOMIC_RELAXED, __HIP_MEMORY_SCOPE_AGENT); }
__device__ __forceinline__ unsigned xb_xcc_id() { return (unsigned)__builtin_amdgcn_s_getreg((3 << 11) | 20) & 0xFu; }
#define XB_SPIN(cond, bar) do { unsigned _sp = 0; while (cond) { __builtin_amdgcn_s_sleep(1); \
    if ((++_sp & 255u) == 0u) { if (xb_ld(&(bar)[XB_TMO])) break; if (_sp > XB_SPIN_CAP) { atomicAdd(&(bar)[XB_TMO], 1u); break; } } } } while (0)
struct XcdBarrier { unsigned* bar; unsigned x; volatile LAS unsigned* st; };
__device__ __forceinline__ XcdBarrier xcd_barrier_post(unsigned* bar, volatile LAS unsigned* st) {
    XcdBarrier b; b.bar = bar; b.x = xb_xcc_id(); b.st = st;
    if (threadIdx.x == 0) (void)xb_add(&bar[XB_XCNT(b.x)], 1u);
    return b;
}
__device__ __forceinline__ void xcd_barrier_complete(unsigned* bar, unsigned x, unsigned& nloc, unsigned& nx) {
    const unsigned G = gridDim.x * gridDim.y * gridDim.z;
    unsigned sum, cnt, mine, sp = 0u;
    for (;;) {
        sum = 0u; cnt = 0u; mine = 0u;
#pragma unroll
        for (unsigned j = 0; j < 16; ++j) { const unsigned c = xb_ld(&bar[XB_XCNT(j)]); sum += c; cnt += (c > 0u) ? 1u : 0u; mine = (j == x) ? c : mine; }
        if (sum == G) break;
        __builtin_amdgcn_s_sleep(1);
        if ((++sp & 255u) == 0u) { if (xb_ld(&bar[XB_TMO])) break; if (sp > XB_SPIN_CAP) { atomicAdd(&bar[XB_TMO], 1u); break; } }
    }
    nloc = mine > 0u ? mine : 1u; nx = cnt > 0u ? cnt : 1u;
}
__device__ __forceinline__ void xcd_barrier(const XcdBarrier& b) {
    asm volatile("s_waitcnt vmcnt(0)" ::: "memory");
    __syncthreads();
    if (threadIdx.x == 0) {
        unsigned* bar = b.bar;
        __builtin_amdgcn_s_waitcnt(0);
        unsigned nloc = b.st[0], nx = b.st[1];
        if (nloc == 0u) { xcd_barrier_complete(bar, b.x, nloc, nx); b.st[0] = nloc; b.st[1] = nx; }
        const unsigned old = xb_add(&bar[XB_XSUB(b.x)], 1u);
        const unsigned gen = old / nloc;
        if (old + 1u == (gen + 1u) * nloc) {
            __builtin_amdgcn_fence(__ATOMIC_RELEASE, "agent");
            asm volatile("s_waitcnt vmcnt(0)" ::: "memory");
            const unsigned og = xb_add(&bar[XB_TOP], 1u);
            const unsigned tg = og / nx;
            if (og + 1u == (tg + 1u) * nx) xb_add(&bar[XB_TOPGEN], 1u);
            else XB_SPIN(xb_ld(&bar[XB_TOPGEN]) == tg, bar);
            __builtin_amdgcn_fence(__ATOMIC_ACQUIRE, "agent");
            xb_add(&bar[XB_XGEN(b.x)], 1u);
            asm volatile("s_waitcnt vmcnt(0)" ::: "memory");
        } else {
            XB_SPIN(xb_ld(&bar[XB_XGEN(b.x)]) == gen, bar);
            __builtin_amdgcn_fence(__ATOMIC_ACQUIRE, "agent");
            asm volatile("s_waitcnt vmcnt(0)" ::: "memory");
        }
    }
    __syncthreads();
}

struct Args { const float* in[24]; float* out; unsigned char* ws; };
struct Frame {
    LAS unsigned char* lds;
    int tid, lane, wave, vcu, G, bid;
};
#define CAS __attribute__((address_space(4)))
__device__ __forceinline__ const CAS char* karg_base() { const CAS char* p = (const CAS char*)__builtin_amdgcn_kernarg_segment_ptr(); asm volatile("" : "+s"(p)); return p; }
#define KIN(i) (*(const float* const CAS*)(karg_base() + 8 * (i)))
#define KOUT() (*(float* const CAS*)(karg_base() + 192))
#define KWS() (*(unsigned char* const CAS*)(karg_base() + 200))

__device__ __forceinline__ void p0_prologue(Frame& F) {
    const int gw = F.bid * NWAVES + F.wave, NGW = F.G * NWAVES, lane = F.lane;
    constexpr int N_GATE = 64 * 256, N_MOE = 3 * N_GATE, N_PROJ = 4 * 768, N_WOUT = 4 * 256, NITEMS = N_MOE + N_PROJ + N_WOUT;
    for (int it = gw; it < NITEMS; it += NGW) {
        const float* W; int pitch, nblk, item, kind; bf16_t* WT;
        if (it < N_MOE) { const int which = it / N_GATE, r = it % N_GATE, mat = r >> 8; item = r & 255; pitch = 1024; nblk = 16;
            W = KIN(21 + which) + (size_t)mat * 1048576;
            if (which < 2) { WT = (bf16_t*)(KWS() + WS_WGU) + (size_t)mat * 2097152; kind = 1 + which; } else { WT = (bf16_t*)(KWS() + WS_WD) + (size_t)mat * 1048576; kind = 0; } }
        else if (it < N_MOE + N_PROJ) { const int r = it - N_MOE, l = r / 768; item = r % 768; nblk = 48; kind = 3;
            if (l & 1) { W = KIN(12) + (size_t)(l >> 1) * 1024 * 3088; pitch = 3088; } else { W = KIN(3) + (size_t)(l >> 1) * 1024 * 3072; pitch = 3072; }
            WT = (bf16_t*)(KWS() + WS_WIN) + (size_t)l * 3145728; }
        else { const int r = it - N_MOE - N_PROJ, l = r >> 8; item = r & 255; nblk = 16; pitch = 1024; kind = 0;
            W = ((l & 1) ? KIN(16) : KIN(11)) + (size_t)(l >> 1) * 1048576; WT = (bf16_t*)(KWS() + WS_WOUT) + (size_t)l * 1048576; }
        const int nb = item % nblk, kb = item / nblk, n = nb * 64 + lane, k0 = kb * 64;
        int drow = n;
        if (kind == 1) drow = ((n >> 7) << 8) + (n & 127);
        else if (kind == 2) drow = ((n >> 7) << 8) + 128 + (n & 127);
        else if (kind == 3) { const int lb = (n >> 5) & 7, pb = 4 * (lb & 1) + (lb >> 1); drow = (n & ~255) + pb * 32 + (n & 31); }
        const float* src = W + (size_t)k0 * pitch + n;
        bf16_t* dst = WT + (size_t)drow * 1024 + k0;
#pragma unroll
        for (int h = 0; h < 2; ++h) {
            float v[32];
#pragma unroll
            for (int i = 0; i < 32; ++i) v[i] = src[(size_t)(h * 32 + i) * pitch];
#pragma unroll
            for (int c = 0; c < 4; ++c) { u32x4 w; w.x = cvt_pk_bf16(v[8 * c], v[8 * c + 1]); w.y = cvt_pk_bf16(v[8 * c + 2], v[8 * c + 3]); w.z = cvt_pk_bf16(v[8 * c + 4], v[8 * c + 5]); w.w = cvt_pk_bf16(v[8 * c + 6], v[8 * c + 7]);
                *(u32x4*)(dst + h * 32 + 8 * c) = w; }
        }
    }
}

__device__ __forceinline__ float reduce16(float (&v)[16], int lane) {
    { const bool b = (lane & 32) != 0;
#pragma unroll
      for (int i = 0; i < 8; ++i) { const float keep = b ? v[i + 8] : v[i], send = b ? v[i] : v[i + 8]; v[i] = keep + xor32_partner(send, b); } }
    { const bool b = (lane & 16) != 0;
#pragma unroll
      for (int i = 0; i < 4; ++i) { const float keep = b ? v[i + 4] : v[i], send = b ? v[i] : v[i + 4]; v[i] = keep + xor_swz<16>(send); } }
    { const bool b = (lane & 8) != 0;
#pragma unroll
      for (int i = 0; i < 2; ++i) { const float keep = b ? v[i + 2] : v[i], send = b ? v[i] : v[i + 2]; v[i] = keep + xor_swz<8>(send); } }
    { const bool b = (lane & 4) != 0; const float keep = b ? v[1] : v[0], send = b ? v[0] : v[1]; v[0] = keep + xor_swz<4>(send); }
    float r = v[0]; r += xor_swz<2>(r); r += xor_swz<1>(r); return r;
}
__device__ __forceinline__ float reduce4(float (&v)[4], int lane) {
    { const bool b = (lane & 32) != 0;
#pragma unroll
      for (int i = 0; i < 2; ++i) { const float keep = b ? v[i + 2] : v[i], send = b ? v[i] : v[i + 2]; v[i] = keep + xor32_partner(send, b); } }
    { const bool b = (lane & 16) != 0; const float keep = b ? v[1] : v[0], send = b ? v[0] : v[1]; v[0] = keep + xor_swz<16>(send); }
    float r = v[0]; r += xor_swz<8>(r); r += xor_swz<4>(r); r += xor_swz<2>(r); r += xor_swz<1>(r); return r;
}

struct RowArgs {
    const float* xin; float* xres; const float* gain; bf16_t* XN;
    const bf16_t* Y; const int* r_e; const int* r_rel; const float* r_w; const unsigned* cnt_prev;
    bool fgate; const float* wf; const float* bf; float* logf;
    const float* wr; const float* br; const float* wg; const float* bg;
    int* o_e; int* o_rel; float* o_w; unsigned* cnt; int* lists;
};
template <int MODE> __device__ __forceinline__ void row_phase(Frame& F, const RowArgs& R) {
    LAS float* wt = (LAS float*)F.lds;
    LAS int* rt_e = (LAS int*)(F.lds + 81920);
    LAS float* rt_w = (LAS float*)(F.lds + 81920 + 512);
    LAS int* rt_rank = (LAS int*)(F.lds + 81920 + 1024);
    LAS int* hist = (LAS int*)(F.lds + 81920 + 1536);
    LAS int* pbase = (LAS int*)(F.lds + MOETAB_OFF + 256);
    const int lane = F.lane, tid = F.tid;
    constexpr bool COMBINE = (MODE == 1 || MODE == 3), ROUTER = (MODE == 2), NORM = (MODE != 3);
    const bool fgate = (MODE <= 1) && R.fgate;
    if (ROUTER) {
        for (int k = tid; k < 1024; k += NWAVES * 64) {
            const f32x4* s = (const f32x4*)(R.wr + (size_t)k * 16);
#pragma unroll
            for (int q = 0; q < 4; ++q) { const f32x4 v = s[q]; wt[(4 * q) * 1024 + k] = v[0]; wt[(4 * q + 1) * 1024 + k] = v[1]; wt[(4 * q + 2) * 1024 + k] = v[2]; wt[(4 * q + 3) * 1024 + k] = v[3]; }
            const f32x4 g = *(const f32x4*)(R.wg + (size_t)k * 4); wt[16 * 1024 + k] = g[0]; wt[17 * 1024 + k] = g[1]; wt[18 * 1024 + k] = g[2]; wt[19 * 1024 + k] = g[3];
        }
        if (tid < 32) hist[tid] = 0;
    }
    if (fgate) {
        for (int k = tid; k < 1024; k += NWAVES * 64) {
            const f32x4* s = (const f32x4*)(R.wf + (size_t)k * 3088);
#pragma unroll
            for (int q = 0; q < 4; ++q) { const f32x4 v = s[q]; wt[(4 * q) * 1024 + k] = v[0]; wt[(4 * q + 1) * 1024 + k] = v[1]; wt[(4 * q + 2) * 1024 + k] = v[2]; wt[(4 * q + 3) * 1024 + k] = v[3]; }
        }
    }
    if (COMBINE) {
        if (tid == 0) { int acc = 0; for (int e = 0; e < 16; ++e) { pbase[e] = acc; acc += (((int)R.cnt_prev[e] + 255) >> 8) << 8; } }
    }
    __syncthreads();
    f32x4 g4[4];
    if (NORM) {
#pragma unroll
        for (int j = 0; j < 4; ++j) g4[j] = *(const f32x4*)(R.gain + 4 * lane + 256 * j);
    }
    for (int blk = F.bid; blk < M / 64; blk += F.G) {
#pragma unroll 1
        for (int rr = 0; rr < 8; ++rr) {
            const int lrow = F.wave * 8 + rr, row = blk * 64 + lrow;
            const f32x4* xr = (const f32x4*)((MODE == 0 ? R.xin : (const float*)R.xres) + (size_t)row * DM) + lane;
            f32x4 x4[4];
#pragma unroll
            for (int j = 0; j < 4; ++j) x4[j] = xr[64 * j];
            if (COMBINE) {
#pragma unroll
                for (int k = 0; k < 2; ++k) {
                    const int e = R.r_e[row * 2 + k], rel = R.r_rel[row * 2 + k]; const float w = R.r_w[row * 2 + k];
                    const size_t pos = (size_t)(pbase[e] + rel);
                    const u32x2* yr = (const u32x2*)(R.Y + pos * DM) + lane;
#pragma unroll
                    for (int j = 0; j < 4; ++j) { const u32x2 y = yr[64 * j]; x4[j][0] += w * bf_lo(y.x); x4[j][1] += w * bf_hi(y.x); x4[j][2] += w * bf_lo(y.y); x4[j][3] += w * bf_hi(y.y); }
                }
            }
            if (MODE != 2) { f32x4* xo = (f32x4*)(R.xres + (size_t)row * DM) + lane;
#pragma unroll
                for (int j = 0; j < 4; ++j) xo[64 * j] = x4[j]; }
            if (NORM) {
                float ss = 0.f;
#pragma unroll
                for (int j = 0; j < 4; ++j) ss += (x4[j][0] * x4[j][0] + x4[j][1] * x4[j][1]) + (x4[j][2] * x4[j][2] + x4[j][3] * x4[j][3]);
                const float rstd = __builtin_amdgcn_rsqf(wave_sum(ss) * (1.f / DM) + EPS);
#pragma unroll
                for (int j = 0; j < 4; ++j) x4[j] = x4[j] * rstd * g4[j];
                u32x2* xo = (u32x2*)(R.XN + (size_t)row * DM) + lane;
#pragma unroll
                for (int j = 0; j < 4; ++j) { u32x2 w; w.x = cvt_pk_bf16(x4[j][0], x4[j][1]); w.y = cvt_pk_bf16(x4[j][2], x4[j][3]); xo[64 * j] = w; }
                if (fgate || ROUTER) {
                    float d[16];
#pragma unroll
                    for (int c = 0; c < 16; ++c) { float a = 0.f;
#pragma unroll
                        for (int j = 0; j < 4; ++j) { const f32x4 w = *(const LAS f32x4*)(wt + c * 1024 + 256 * j + 4 * lane); a += (x4[j][0] * w[0] + x4[j][1] * w[1]) + (x4[j][2] * w[2] + x4[j][3] * w[3]); }
                        d[c] = a; }
                    const float rl = reduce16(d, lane);
                    if (fgate) {
                        const int h = lane >> 2; const float z = rl + R.bf[h];
                        const float ls = fminf(z, 0.f) - 0.6931471805599453f * __builtin_amdgcn_logf(1.f + __builtin_amdgcn_exp2f(-fabsf(z) * LOG2E));
                        if ((lane & 3) == 0) R.logf[(size_t)row * 16 + h] = ls;
                    }
                    if (ROUTER) {
                        float dg[4];
#pragma unroll
                        for (int c = 0; c < 4; ++c) { float a = 0.f;
#pragma unroll
                            for (int j = 0; j < 4; ++j) { const f32x4 w = *(const LAS f32x4*)(wt + (16 + c) * 1024 + 256 * j + 4 * lane); a += (x4[j][0] * w[0] + x4[j][1] * w[1]) + (x4[j][2] * w[2] + x4[j][3] * w[3]); }
                            dg[c] = a; }
                        const float gl_ = reduce4(dg, lane);
                        float gl[4];
#pragma unroll
                        for (int c = 0; c < 4; ++c) gl[c] = __int_as_float(__builtin_amdgcn_readlane(__float_as_int(gl_), 16 * c)) + R.bg[c];
                        int gi = 0; float gm = gl[0];
#pragma unroll
                        for (int c = 1; c < 4; ++c) if (gl[c] > gm) { gm = gl[c]; gi = c; }
                        float gs = 0.f;
#pragma unroll
                        for (int c = 0; c < 4; ++c) gs += __builtin_amdgcn_exp2f((gl[c] - gm) * LOG2E);
                        const float gw = __builtin_amdgcn_rcpf(gs);
                        gi = __builtin_amdgcn_readfirstlane(gi);
                        float el[4];
#pragma unroll
                        for (int c = 0; c < 4; ++c) el[c] = __int_as_float(__builtin_amdgcn_readlane(__float_as_int(rl), 4 * (4 * gi + c))) + R.br[4 * gi + c];
                        int i0 = 0; float v0 = el[0];
#pragma unroll
                        for (int c = 1; c < 4; ++c) if (el[c] > v0) { v0 = el[c]; i0 = c; }
                        int i1 = -1; float v1 = -INFINITY;
#pragma unroll
                        for (int c = 0; c < 4; ++c) if (c != i0 && el[c] > v1) { v1 = el[c]; i1 = c; }
                        const float p0 = __builtin_amdgcn_rcpf(1.f + __builtin_amdgcn_exp2f((v1 - v0) * LOG2E));
                        if (lane == 0) { rt_e[2 * lrow] = 4 * gi + i0; rt_e[2 * lrow + 1] = 4 * gi + i1; rt_w[2 * lrow] = p0 * gw; rt_w[2 * lrow + 1] = (1.f - p0) * gw; }
                    }
                }
            }
        }
        if (ROUTER) {
            __syncthreads();
            int e = 0;
            if (tid < 128) { e = rt_e[tid]; rt_rank[tid] = atomicAdd((int*)(hist + e), 1); }
            __syncthreads();
            if (tid < 16) hist[16 + tid] = (int)atomicAdd(R.cnt + tid, (unsigned)hist[tid]);
            __syncthreads();
            if (tid < 128) { const int row = blk * 64 + (tid >> 1), k = tid & 1, rel = hist[16 + e] + rt_rank[tid];
                R.o_e[row * 2 + k] = e; R.o_rel[row * 2 + k] = rel; R.o_w[row * 2 + k] = rt_w[tid]; R.lists[e * LISTCAP + rel] = row; }
            __syncthreads();
            if (tid < 16) hist[tid] = 0;
            __syncthreads();
        }
    }
}

__device__ __forceinline__ void cumsum_phase(Frame& F, const float* logf, float* ftabg, int* jsg, float T) {
    LAS float* tot = (LAS float*)F.lds;
    LAS float* fl = (LAS float*)(F.lds + 4096);
    for (int bh = F.bid; bh < 32; bh += F.G) {
        const int b = bh >> 4, h = bh & 15, t0 = F.tid * 16;
        float v[16]; float run = 0.f;
#pragma unroll
        for (int j = 0; j < 16; ++j) { run += logf[(size_t)(b * SEQ + t0 + j) * 16 + h]; v[j] = run; }
        tot[F.tid] = run;
        __syncthreads();
        if (F.tid < 8) { float a = 0.f; for (int j = 0; j < 64; ++j) a += tot[F.tid * 64 + j]; tot[512 + F.tid] = a; }
        __syncthreads();
        float base = 0.f;
        for (int w = 0; w < F.wave; ++w) base += tot[512 + w];
        for (int j = 0; j < 63; ++j) { const float u = tot[F.wave * 64 + j]; base += (j < F.lane) ? u : 0.f; }
        float* dst = ftabg + (size_t)bh * SEQ + t0;
#pragma unroll
        for (int j = 0; j < 16; j += 4) { const f32x4 o = (f32x4){(base + v[j]) * LOG2E, (base + v[j + 1]) * LOG2E, (base + v[j + 2]) * LOG2E, (base + v[j + 3]) * LOG2E};
            *(f32x4*)(dst + j) = o; *(LAS f32x4*)(fl + t0 + j) = o; }
        __syncthreads();
        if (F.tid < 32) { const int qb = F.tid, nt = 4 * qb + 4; const float lim = fl[256 * qb] + T; int js = 0;
            while (js < nt - 4 && fl[64 * js + 63] > lim) ++js;
            jsg[bh * 32 + qb] = js & ~1; }
        __syncthreads();
    }
}

__device__ __forceinline__ void acombine_phase(Frame& F, const bf16_t* AO, bf16_t* O, const float* lq1, const float* lk1, const float* lq2, const float* lk2, const float* subg, float lam_init) {
    const int lane = F.lane;
    const float s1 = wave_sum(lq1[lane] * lk1[lane]), s2 = wave_sum(lq2[lane] * lk2[lane]);
    const float lam = __builtin_amdgcn_exp2f(s1 * LOG2E) - __builtin_amdgcn_exp2f(s2 * LOG2E) + lam_init, osc = 1.f - lam_init;
    const int hA = lane >> 4, j0 = (lane & 15) * 8;
    float g[8];
#pragma unroll
    for (int i = 0; i < 8; ++i) g[i] = subg[j0 + i] * osc;
    const int gw = F.bid * NWAVES + F.wave, NGW = F.G * NWAVES;
    for (int row = gw; row < M; row += NGW) {
        const u32x4 a = *(const u32x4*)(AO + (size_t)row * DM + hA * 256 + j0), b = *(const u32x4*)(AO + (size_t)row * DM + hA * 256 + 128 + j0);
        float d[8];
        d[0] = bf_lo(a.x) - lam * bf_lo(b.x); d[1] = bf_hi(a.x) - lam * bf_hi(b.x); d[2] = bf_lo(a.y) - lam * bf_lo(b.y); d[3] = bf_hi(a.y) - lam * bf_hi(b.y);
        d[4] = bf_lo(a.z) - lam * bf_lo(b.z); d[5] = bf_hi(a.z) - lam * bf_hi(b.z); d[6] = bf_lo(a.w) - lam * bf_lo(b.w); d[7] = bf_hi(a.w) - lam * bf_hi(b.w);
        float ss = 0.f;
#pragma unroll
        for (int i = 0; i < 8; ++i) ss += d[i] * d[i];
        ss += xor_swz<1>(ss); ss += xor_swz<2>(ss); ss += xor_swz<4>(ss); ss += xor_swz<8>(ss);
        const float rstd = __builtin_amdgcn_rsqf(ss * (1.f / 128.f) + EPS);
        u32x4 w; w.x = cvt_pk_bf16(d[0] * rstd * g[0], d[1] * rstd * g[1]); w.y = cvt_pk_bf16(d[2] * rstd * g[2], d[3] * rstd * g[3]);
        w.z = cvt_pk_bf16(d[4] * rstd * g[4], d[5] * rstd * g[5]); w.w = cvt_pk_bf16(d[6] * rstd * g[6], d[7] * rstd * g[7]);
        *(u32x4*)(O + (size_t)row * DM + hA * 128 + j0) = w;
    }
}

__global__ void __launch_bounds__(NWAVES * 64, 2) hybrid_fwd(Args args_unused) {
    extern __shared__ __attribute__((aligned(16))) unsigned char lds[];
    Frame F;
    F.lds = (LAS unsigned char*)lds;
    const int wave_s = __builtin_amdgcn_readfirstlane((int)threadIdx.x >> 6);
    F.tid = threadIdx.x; F.lane = F.tid & 63; F.wave = wave_s;
    F.G = gridDim.x; F.bid = blockIdx.x; { const int bx = blockIdx.x; F.vcu = (F.G % 8 == 0) ? (bx % 8) * (F.G / 8) + bx / 8 : bx; }
#define WSB KWS()
#define CTLP ((unsigned*)(KWS() + WS_CTL))
    volatile LAS unsigned* MISC = (volatile LAS unsigned*)(F.lds + MISC_OFF);
    for (int u = F.tid; u < (LDS_BYTES - LDSCTL_OFF) / 4; u += NWAVES * 64) ((LAS unsigned*)(F.lds + LDSCTL_OFF))[u] = 0u;
    __syncthreads();
    (void)xcd_barrier_post(CTLP + CW_BAR, MISC + 8);
#define RELAUNDER() do { int l_; asm volatile("v_mbcnt_lo_u32_b32 %0, -1, 0\n\tv_mbcnt_hi_u32_b32 %0, -1, %0" : "=&v"(l_)); F.lane = l_; F.tid = wave_s * 64 + l_; F.wave = wave_s; } while (0)
#define FRESH_TID(var) int var; do { int l_; asm volatile("v_mbcnt_lo_u32_b32 %0, -1, 0\n\tv_mbcnt_hi_u32_b32 %0, -1, %0" : "=&v"(l_)); var = wave_s * 64 + l_; } while (0)
#define GRID_BAR() do { XcdBarrier b_; b_.bar = CTLP + CW_BAR; b_.x = xb_xcc_id(); b_.st = MISC + 8; xcd_barrier(b_); RELAUNDER(); } while (0)

#define P_XN ((bf16_t*)(WSB + WS_XN))
#define P_QKV ((bf16_t*)(WSB + WS_QKV))
#define P_OB ((bf16_t*)(WSB + WS_O))
#define P_AO ((bf16_t*)(WSB + WS_AO))
#define P_HB ((bf16_t*)(WSB + WS_H))
#define P_YB ((bf16_t*)(WSB + WS_Y))
#define P_FTABG ((float*)(WSB + WS_FTAB))
#define P_LOGF ((float*)(WSB + WS_LOGF))
#define P_RE ((int*)(WSB + WS_ROUTE))
#define P_RREL (P_RE + 2 * M)
#define P_RW ((float*)(P_RREL + 2 * M))
#define P_LISTS ((int*)(WSB + WS_LISTS))
    LAS float* gtab = (LAS float*)(F.lds + GTAB_OFF);
    LAS int* moetab = (LAS int*)(F.lds + MOETAB_OFF);

    for (int rep_ = 0; rep_ < REP_P0; ++rep_) p0_prologue(F);
    GRID_BAR();

#pragma unroll 1
    for (int layer = 0; layer < DEPTH; ++layer) {
        const int li = layer >> 1; const bool odd = (layer & 1) != 0;
        {
            RowArgs R{};
            R.xin = KIN(0); R.xres = KOUT(); R.gain = KIN(1) + layer * DM; R.XN = P_XN;
            R.Y = P_YB; R.r_e = P_RE; R.r_rel = P_RREL; R.r_w = P_RW; R.cnt_prev = CTLP + CW_CNT + 64 * (layer > 0 ? layer - 1 : 0);
            R.fgate = odd; R.wf = KIN(12) + (size_t)li * 1024 * 3088 + 3072; R.bf = KIN(13) + li * 16; R.logf = P_LOGF;
            if (layer == 0) row_phase<0>(F, R); else row_phase<1>(F, R);
        }
        GRID_BAR();
        {
            if (odd) { const float* gq = KIN(14) + li * 64; const float* gk = KIN(15) + li * 64;
                const float Bp = 1.03f * 8.f * wave_max(fabsf(gq[F.lane])) * wave_max(fabsf(gk[F.lane])) * LOG2E + 0.5f;
                cumsum_phase(F, P_LOGF, P_FTABG, (int*)(WSB + WS_JS), 2.f * Bp + 152.f); }
            if (F.tid < 128) { const float* gq = odd ? KIN(14) + li * 64 : KIN(4) + li * 64; const float* gk = odd ? KIN(15) + li * 64 : KIN(5) + li * 64;
                gtab[F.tid] = F.tid < 64 ? gq[F.tid] * C2 : gk[F.tid - 64]; }
            __syncthreads();
            pg8::ProjSched S; S.so.init(M, NQKV, F.G, F.bid); S.A = (const char*)P_XN; S.W = (const char*)(WSB + WS_WIN) + (size_t)layer * 3145728 * 2;
            if (odd) { S.mq = 4; S.mk = 8; S.s_lo = 0; S.s_hi = 0; } else { S.mq = 2; S.mk = 4; S.s_lo = 6; S.s_hi = 8; }
            pg8::EpiProj E{P_QKV, gtab};
            for (int rep_ = 0; rep_ < REP_PROJ; ++rep_) { int t_ = F.tid; asm volatile("" : "+v"(t_)); pg8::gemm_phase<pg8::EpiProj, pg8::ProjSched, false>(F.lds, S, E, t_); }
        }
        GRID_BAR();
        {
            using abf = att::bf16;
            const float* gq = odd ? KIN(14) + li * 64 : KIN(4) + li * 64; const float* gk = odd ? KIN(15) + li * 64 : KIN(5) + li * 64;
            const float Bp = 1.03f * 8.f * wave_max(fabsf(gq[F.lane])) * wave_max(fabsf(gk[F.lane])) * LOG2E + 0.5f;
            LAS float* ftab = (LAS float*)(F.lds + att::LDS_FTAB);
            LAS int* jsl = (LAS int*)(F.lds + JSL_OFF);
            const float Tskip = 2.f * Bp + 152.f;
            if (odd) { const int* jsg = (const int*)(WSB + WS_JS); for (int i = F.tid; i < 1024; i += NWAVES * 64) jsl[i] = jsg[i]; }
            else { for (int i = F.tid; i < 1024; i += NWAVES * 64) { const int vh = i >> 5, qb = i & 31, hA = (vh >> 2) & 3;
                    const float slope = __builtin_amdgcn_exp2f(-2.f * (float)(hA + 1)) * LOG2E;
                    const float jf = ((float)(256 * qb - 63) - Tskip / slope) * (1.f / 64.f);
                    int js = jf > 0.f ? (int)jf : 0; js = js < 4 * qb ? js : 4 * qb; jsl[i] = js & ~1; } }
            __syncthreads();
            const int home = (int)(xb_xcc_id() & 7u);
            const int nrep_att = odd ? REP_ATT_ODD : REP_ATT_EVEN;
            for (int rep_ = 0; rep_ < nrep_att; ++rep_) {
                unsigned* qh = CTLP + CW_ATTQ + (layer * 2 + rep_) * 512;
#pragma unroll 1
                for (int kk = 0; kk < 8; ++kk) { const int x = (home + kk) & 7;
#pragma unroll 1
                    for (;;) {
                        FRESH_TID(tf);
                        if (tf == 0) MISC[16] = xb_add(qh + 64 * x, 1u);
                        __syncthreads();
                        const int i = (int)MISC[16];
                        __syncthreads();
                        if (i >= 128) break;
                        const int vh = 4 * x + ((i >> 3) & 3), qb = 31 - (8 * (i >> 5) + (i & 7));
                        const int js = __builtin_amdgcn_readfirstlane(jsl[vh * 32 + qb]);
                        const int b = vh >> 4;
                        const abf *Qh, *Kh, *Vh; abf* Oh;
                        const abf* base = (const abf*)P_QKV + (size_t)b * SEQ * PQ;
                        if (odd) { const int h = vh & 15; Qh = base + h * 64; Kh = base + 1024 + h * 64; Vh = base + 2048 + h * 64; Oh = (abf*)P_OB + (size_t)b * SEQ * DM + h * 64;
                            const f32x4* src = (const f32x4*)(P_FTABG + (size_t)vh * SEQ);
                            for (int j = 16 * js + tf; j < 64 * qb + 64; j += NWAVES * 64) ((LAS f32x4*)ftab)[j] = src[j];
                        } else { const int hA = (vh >> 2) & 3, mp = (vh >> 1) & 1, vhalf = vh & 1;
                            Qh = base + hA * 128 + mp * 64; Kh = base + 512 + hA * 128 + mp * 64; Vh = base + 1024 + hA * 128 + vhalf * 64; Oh = (abf*)P_AO + (size_t)b * SEQ * DM + hA * 256 + mp * 128 + vhalf * 64;
                            const float slope = __builtin_amdgcn_exp2f(-2.f * (float)(hA + 1)) * LOG2E;
                            for (int j = 64 * js + tf; j < 256 * qb + 256; j += NWAVES * 64) ftab[j] = -slope * (float)j;
                        }
                        __syncthreads();
                        { FRESH_TID(t_); att::attn_unit_b<DM>(qb, js, Qh, Kh, Vh, Oh, Bp, (char*)lds, t_); }
                    }
                }
            }
            if (!odd) {
                for (int rep_ = 0; rep_ < REP_SB; ++rep_)
#pragma unroll 1
                for (int u = F.vcu; u < 512; u += F.G) {
                    const int uu = (u & 255) * 2 + (u >> 8);
                    const int bh = uu >> 5, qb = uu & 31, b = bh >> 3, hB = bh & 7;
                    const abf* base = (const abf*)P_QKV + (size_t)b * SEQ * PQ;
                    FRESH_TID(t_);
                    att::sb_unit<DM>(qb, base + 1536 + hB * 64, base + 2048 + hB * 64, base + 2560 + hB * 64, (abf*)P_OB + (size_t)b * SEQ * DM + 512 + hB * 64, (char*)lds, t_);
                }
            }
        }
        GRID_BAR();
        if (!odd) {
            const float lam_init = 0.8f - 0.6f * __builtin_amdgcn_exp2f(-0.3f * LOG2E * (float)layer);
            for (int rep_ = 0; rep_ < REP_ACOMB; ++rep_) acombine_phase(F, P_AO, P_OB, KIN(6) + li * 64, KIN(7) + li * 64, KIN(8) + li * 64, KIN(9) + li * 64, KIN(10) + li * 128, lam_init);
            GRID_BAR();
        }
        {
            pg8::WoutSched S; S.so.init(M, DM, F.G, F.bid); S.A = (const char*)P_OB; S.W = (const char*)(WSB + WS_WOUT) + (size_t)layer * 1048576 * 2;
            pg8::EpiResid E{KOUT()};
            pg8::gemm_phase<pg8::EpiResid, pg8::WoutSched, false>(F.lds, S, E, F.tid);
        }
        GRID_BAR();
        {
            RowArgs R{};
            R.xin = KIN(0); R.xres = KOUT(); R.gain = KIN(2) + layer * DM; R.XN = P_XN;
            R.wr = KIN(19) + (size_t)layer * 1024 * 16; R.br = KIN(20) + layer * 16; R.wg = KIN(17) + (size_t)layer * 1024 * 4; R.bg = KIN(18) + layer * 4;
            R.o_e = P_RE; R.o_rel = P_RREL; R.o_w = P_RW; R.cnt = CTLP + CW_CNT + 64 * layer; R.lists = P_LISTS;
            row_phase<2>(F, R);
        }
        GRID_BAR();
        {
            if (F.tid == 0) { int acc = 0; for (int e = 0; e < 16; ++e) { const int c = (int)CTLP[CW_CNT + 64 * layer + e]; moetab[e] = acc; moetab[17 + e] = c; acc += (c + 255) >> 8; } moetab[16] = acc; }
            __syncthreads();
            pg8::MoeSched<8, true> S{moetab, F.G, F.bid, (const char*)P_XN, (const char*)(WSB + WS_WGU) + (size_t)layer * 16 * 2097152 * 2, P_LISTS};
            pg8::EpiSwiGLU E{P_HB};
            for (int rep_ = 0; rep_ < REP_UP; ++rep_) pg8::gemm_phase<pg8::EpiSwiGLU, pg8::MoeSched<8, true>, true>(F.lds, S, E, F.tid);
        }
        GRID_BAR();
        {
            pg8::MoeSched<4, false> S{moetab, F.G, F.bid, (const char*)P_HB, (const char*)(WSB + WS_WD) + (size_t)layer * 16 * 1048576 * 2, P_LISTS};
            pg8::EpiBf16 E{P_YB};
            for (int rep_ = 0; rep_ < REP_DOWN; ++rep_) pg8::gemm_phase<pg8::EpiBf16, pg8::MoeSched<4, false>, false>(F.lds, S, E, F.tid);
        }
        GRID_BAR();
    }
    {
        RowArgs R{};
        R.xin = KIN(0); R.xres = KOUT(); R.gain = KIN(1); R.XN = P_XN;
        R.Y = P_YB; R.r_e = P_RE; R.r_rel = P_RREL; R.r_w = P_RW; R.cnt_prev = CTLP + CW_CNT + 64 * (DEPTH - 1);
        row_phase<3>(F, R);
    }
    if (xb_ld(CTLP + CW_BAR + XB_TMO) != 0u) {
        VM_WAIT(); __syncthreads();
        const float qn = __builtin_nanf("");
        for (size_t i = (size_t)F.bid * 512 + F.tid; i < (size_t)M * DM; i += (size_t)F.G * 512) KOUT()[i] = qn;
    }
#undef GRID_BAR
}

#undef P_XN
#undef P_QKV
#undef P_OB
#undef P_AO
#undef P_HB
#undef P_YB
#undef P_FTABG
#undef P_LOGF
#undef P_RE
#undef P_RREL
#undef P_RW
#undef P_LISTS
#undef WSB
#undef CTLP
extern "C" void kernel_launch(void* const* d_in, const int* in_sizes, int n_in, void* d_out, int out_size, void* d_ws, size_t ws_size, hipStream_t stream) {
    static int grid = 0;
    if (grid == 0) {
        if (n_in != 24 || in_sizes[0] != M * DM || out_size != M * DM || ws_size < WS_END) { fprintf(stderr, "kernel_launch: unexpected shapes (n_in %d, in0 %d, out %d, ws %zu); nothing launched\n", n_in, n_in > 0 ? in_sizes[0] : -1, out_size, ws_size); grid = -1; return; }
        int dev = 0, cus = 0, per_cu = 0;
        if (hipGetDevice(&dev) != hipSuccess || hipDeviceGetAttribute(&cus, hipDeviceAttributeMultiprocessorCount, dev) != hipSuccess) { grid = -1; return; }
        if (hipFuncSetAttribute((const void*)hybrid_fwd, hipFuncAttributeMaxDynamicSharedMemorySize, LDS_BYTES) != hipSuccess) { fprintf(stderr, "kernel_launch: hipFuncSetAttribute failed\n"); grid = -1; return; }
        if (hipOccupancyMaxActiveBlocksPerMultiprocessor(&per_cu, (const void*)hybrid_fwd, NWAVES * 64, LDS_BYTES) != hipSuccess || per_cu < 1)
            fprintf(stderr, "kernel_launch: note: occupancy query reports %d workgroups per CU\n", per_cu);
        (void)hipGetLastError();
        grid = cus;
        if (grid != 256) fprintf(stderr, "kernel_launch: %d CUs; the attention schedule assumes 256\n", grid);
    }
    if (grid < 0) return;
    if (hipMemsetAsync((char*)d_ws + WS_CTL, 0, CTL_ZERO_BYTES, stream) != hipSuccess) return;
    Args a{};
    for (int i = 0; i < 24; ++i) a.in[i] = (const float*)d_in[i];
    a.out = (float*)d_out; a.ws = (unsigned char*)d_ws;
    hipLaunchKernelGGL(hybrid_fwd, dim3(grid), dim3(NWAVES * 64), LDS_BYTES, stream, a);
}
```

```cpp
#include <hip/hip_runtime.h>
#include <hip/hip_bf16.h>
#include <cstdio>
#include <cstdint>
#include <cmath>

#define GAS __attribute__((address_space(1)))
#define LAS __attribute__((address_space(3)))
typedef unsigned short bf16_t;
typedef short bf16x8 __attribute__((ext_vector_type(8)));
typedef short s16x4 __attribute__((ext_vector_type(4)));
typedef float f32x2 __attribute__((ext_vector_type(2)));
typedef float f32x4 __attribute__((ext_vector_type(4)));
typedef float f32x16 __attribute__((ext_vector_type(16)));
typedef unsigned u32x2 __attribute__((ext_vector_type(2)));
typedef unsigned u32x4 __attribute__((ext_vector_type(4)));

constexpr int BATCH = 2, SEQ = 8192, DM = 1024, M = BATCH * SEQ, DEPTH = 4;
constexpr int NQKV = 3072, PQ = 3072;
constexpr int NEXP = 16, LISTCAP = 16384, PMAX = 36864;
constexpr float EPS = 1e-6f;
constexpr float LOG2E = 1.4426950408889634f, C2 = 0.125f * LOG2E;
constexpr int NWAVES = 8;
#ifndef PROBE
#define PROBE 0
#endif
constexpr int REP_P0 = (PROBE == 1) ? 2 : 1, REP_PROJ = (PROBE == 2) ? 2 : 1, REP_ATT_EVEN = (PROBE == 3) ? 2 : 1, REP_SB = (PROBE == 4) ? 2 : 1, REP_ATT_ODD = (PROBE == 5) ? 2 : 1,
              REP_UP = (PROBE == 6) ? 2 : 1, REP_DOWN = (PROBE == 7) ? 2 : 1, REP_ACOMB = (PROBE == 8) ? 2 : 1;

constexpr size_t MiB = 1u << 20;
constexpr size_t WS_CTL = 0, CTL_ZERO_BYTES = 1 * MiB;
constexpr size_t WS_FTAB = 2 * MiB;
constexpr size_t WS_LOGF = 3 * MiB;
constexpr size_t WS_ROUTE = 4 * MiB;
constexpr size_t WS_LISTS = 5 * MiB;
constexpr size_t WS_JS = 6 * MiB;
constexpr size_t WS_WIN = 8 * MiB;
constexpr size_t WS_WOUT = 32 * MiB;
constexpr size_t WS_WGU = 40 * MiB;
constexpr size_t WS_WD = 296 * MiB;
constexpr size_t WS_XN = 424 * MiB;
constexpr size_t WS_QKV = 456 * MiB;
constexpr size_t WS_O = 552 * MiB;
constexpr size_t WS_AO = 584 * MiB;
constexpr size_t WS_H = 616 * MiB;
constexpr size_t WS_Y = 688 * MiB;
constexpr size_t WS_END = 760 * MiB;
constexpr int CW_BAR = 4096;
constexpr int CW_CNT = 1024;
constexpr int CW_ATTQ = 8192;

constexpr int RING_BYTES = 131072;
constexpr int LDSCTL_OFF = RING_BYTES, MISC_OFF = LDSCTL_OFF + 320;
constexpr int GTAB_OFF = LDSCTL_OFF + 1024;
constexpr int MOETAB_OFF = LDSCTL_OFF + 2048;
constexpr int JSL_OFF = LDSCTL_OFF + 4096;
constexpr int PERM_OFF = LDSCTL_OFF + 8192;
constexpr int LDS_BYTES = 147456;

#define RLX_AGENT __ATOMIC_RELAXED, __HIP_MEMORY_SCOPE_AGENT
#define LDS_WAIT() asm volatile("s_waitcnt lgkmcnt(0)" ::: "memory")
#define VM_WAIT() asm volatile("s_waitcnt vmcnt(0)" ::: "memory")
__device__ __forceinline__ unsigned cvt_pk_bf16(float lo, float hi) { unsigned r; asm volatile("v_cvt_pk_bf16_f32 %0, %1, %2" : "=v"(r) : "v"(lo), "v"(hi)); return r; }
__device__ __forceinline__ float bf_lo(unsigned u) { return __uint_as_float(u << 16); }
__device__ __forceinline__ float bf_hi(unsigned u) { return __uint_as_float(u & 0xffff0000u); }
template <int MSK> __device__ __forceinline__ float xor_swz(float v) { return __int_as_float(__builtin_amdgcn_ds_swizzle(__float_as_int(v), (MSK << 10) | 0x1F)); }
__device__ __forceinline__ float xor32_partner(float v, bool upper) { auto rr = __builtin_amdgcn_permlane32_swap(__float_as_uint(v), __float_as_uint(v), false, false); return __uint_as_float(upper ? rr[0] : rr[1]); }
__device__ __forceinline__ float xor32_sum(float v) { auto rr = __builtin_amdgcn_permlane32_swap(__float_as_uint(v), __float_as_uint(v), false, false); return __uint_as_float(rr[0]) + __uint_as_float(rr[1]); }
__device__ __forceinline__ float wave_sum(float v) {
    v += xor_swz<1>(v); v += xor_swz<2>(v); v += xor_swz<4>(v); v += xor_swz<8>(v); v += xor_swz<16>(v); return xor32_sum(v);
}
__device__ __forceinline__ float wave_max(float v) {
    v = fmaxf(v, xor_swz<1>(v)); v = fmaxf(v, xor_swz<2>(v)); v = fmaxf(v, xor_swz<4>(v)); v = fmaxf(v, xor_swz<8>(v)); v = fmaxf(v, xor_swz<16>(v));
    auto rr = __builtin_amdgcn_permlane32_swap(__float_as_uint(v), __float_as_uint(v), false, false); return fmaxf(__uint_as_float(rr[0]), __uint_as_float(rr[1]));
}

namespace pg8 {
constexpr int BM = 256, BK = 64, HALF = 128, HTB = HALF * BK * 2, STAGE_BYTES = 8 * HTB, NXCD = 8, WGM = 8, K = 1024;
__host__ __device__ __forceinline__ int lds_byte(int r, int c) { const int st = (r >> 4) * 2 + (c >> 5), rr = r & 15, cc = c & 31, ob = rr * 64 + cc * 2; return st * 1024 + (ob ^ (((ob >> 9) & 1) << 5)); }
__host__ __device__ __forceinline__ void stage_rc(int b, int& R, int& C) { const int st = b / 1024, sb = b % 1024, swz = sb ^ (((sb >> 9) & 1) << 5); R = (st >> 1) * 16 + swz / 64; C = (st & 1) * 32 + (swz % 64) / 2; }
__host__ __device__ __forceinline__ int perm32(int rho) { const int n = rho >> 4, i = rho & 15; return 8 * (i >> 2) + 4 * n + (i & 3); }

struct Unit {
    const char* a;
    const char* b;
    const int* list;
    int nvalid;
    int row0, col0;
    int mode;
};

struct StaticOrder {
    int nM, nN, nwg, G, c;
    __device__ void init(int M_, int N_, int G_, int c_) { nM = M_ / BM; nN = N_ / BM; nwg = nM * nN; G = G_; c = c_; }
    __device__ bool next(int i, int& pm, int& pn) const {
        const long L = (long)i * G + c; if (L >= nwg) return false;
        int wgid = (int)L; { const int q = nwg / NXCD, r = nwg % NXCD, xcd = wgid % NXCD, off = wgid / NXCD; wgid = (xcd < r ? xcd * (q + 1) : r * (q + 1) + (xcd - r) * q) + off; }
        const int nig = WGM * nN, gid = wgid / nig, fm = gid * WGM, gsz = (nM - fm) < WGM ? (nM - fm) : WGM;
        pm = fm + ((wgid % nig) % gsz); pn = (wgid % nig) / gsz; return true;
    }
};

typedef f32x4 Acc[2][2][4][2];

template <class Epi, class Sched, bool GATHER>
__device__ __forceinline__ void gemm_phase(LAS unsigned char* lds, const Sched& S, const Epi& E, const int tid) {
    const int wid = __builtin_amdgcn_readfirstlane(tid >> 6), lane = tid & 63, wr = wid >> 2, wc = wid & 3, fr = lane & 15, fq = lane >> 4;
    constexpr int nt = K / BK;
    unsigned voffB[2], vA[2][2], vN[2][2];
#pragma unroll
    for (int i = 0; i < 2; ++i) { int R, C; stage_rc(tid * 16 + i * 8192, R, C); const int Rb = Epi::PERM ? ((R & ~31) + perm32(R & 31)) : R;
        voffB[i] = (unsigned)(Rb * K + C) * 2u;
        vA[0][i] = (unsigned)(R * K + C) * 2u; vA[1][i] = vA[0][i]; vN[0][i] = vA[0][i]; vN[1][i] = vA[0][i]; }
    constexpr size_t hA = GATHER ? (size_t)0 : (size_t)HALF * K * 2;
    constexpr size_t kstep = (size_t)(BK * 2);
    constexpr size_t hstep = (size_t)HALF * K * 2;
    const unsigned ldsw = (unsigned)wid * 1024u;
    const int aoff = lds_byte(wr * 64 + fr, fq * 8), boff = lds_byte(wc * 32 + fr, fq * 8);
#define PG8_SA(b, h) (((b) * 2 + (h)) * HTB)
#define PG8_SB(b, h) ((4 + (b) * 2 + (h)) * HTB)
#define PG8_STAGE(bufoff, gbase, voff) do { _Pragma("unroll") for (int _i = 0; _i < 2; ++_i) \
        __builtin_amdgcn_global_load_lds((const unsigned*)((const char*)(gbase) + (voff)[_i]), (LAS unsigned*)(lds + (bufoff) + ldsw + _i * 8192), 16, 0, 0); } while (0)
#define PG8_LDA(dst, b, h) do { _Pragma("unroll") for (int m = 0; m < 4; ++m) _Pragma("unroll") for (int k = 0; k < 2; ++k) dst[m][k] = *(const LAS bf16x8*)(lds + PG8_SA(b, h) + aoff + m * 2048 + k * 1024); } while (0)
#define PG8_LDB(dst, b, h) do { _Pragma("unroll") for (int n = 0; n < 2; ++n) _Pragma("unroll") for (int k = 0; k < 2; ++k) dst[n][k] = *(const LAS bf16x8*)(lds + PG8_SB(b, h) + boff + n * 2048 + k * 1024); } while (0)
#define PG8_MMA(ai, bj, At, Bt) do { __builtin_amdgcn_s_setprio(1); _Pragma("unroll") for (int m = 0; m < 4; ++m) _Pragma("unroll") for (int n = 0; n < 2; ++n) _Pragma("unroll") for (int k = 0; k < 2; ++k) \
        acc[ai][bj][m][n] = __builtin_amdgcn_mfma_f32_16x16x32_bf16(Bt[n][k], At[m][k], acc[ai][bj][m][n], 0, 0, 0); __builtin_amdgcn_s_setprio(0); } while (0)
#define PG8_WAIT_V(n) asm volatile("s_waitcnt vmcnt(" #n ")" ::: "memory")
#define PG8_WAIT_L(n) asm volatile("s_waitcnt lgkmcnt(" #n ")" ::: "memory")
#define PG8_BAR __builtin_amdgcn_s_barrier()
#define PG8_SCHED __builtin_amdgcn_sched_barrier(0)
#define PG8_GVOFF(u, vo) do { _Pragma("unroll") for (int _h = 0; _h < 2; ++_h) _Pragma("unroll") for (int _i = 0; _i < 2; ++_i) { int _R, _C; stage_rc(tid * 16 + _i * 8192, _R, _C); \
        const int _idx = _h * HALF + _R; const int _tok = (_idx < (u).nvalid) ? (u).list[_idx] : 0; vo[_h][_i] = (unsigned)(_tok * K + _C) * 2u; } } while (0)
    Unit cur, nxt; int ui = 0;
    if (!S.next(0, cur)) return;
    if constexpr (GATHER) { PG8_GVOFF(cur, vA); }
    Acc acc;
#pragma unroll
    for (int a = 0; a < 2; ++a)
#pragma unroll
        for (int b = 0; b < 2; ++b)
#pragma unroll
            for (int m = 0; m < 4; ++m)
#pragma unroll
                for (int n = 0; n < 2; ++n) acc[a][b][m][n] = (f32x4){0.f, 0.f, 0.f, 0.f};
    bf16x8 At[4][2], B0[2][2], B1[2][2];
    const char* cA = cur.a; const char* cB = cur.b;
    PG8_STAGE(PG8_SB(0, 0), cB, voffB); PG8_STAGE(PG8_SB(0, 1), cB + hstep, voffB); PG8_STAGE(PG8_SA(0, 0), cA, vA[0]); PG8_STAGE(PG8_SA(0, 1), cA + hA, vA[GATHER ? 1 : 0]);
    if (wr == 1) PG8_BAR;
    PG8_WAIT_V(2); PG8_BAR;
    PG8_STAGE(PG8_SB(1, 0), cB + kstep, voffB); PG8_STAGE(PG8_SA(1, 0), cA + kstep, vA[0]); PG8_STAGE(PG8_SB(1, 1), cB + hstep + kstep, voffB);
    PG8_WAIT_V(6); PG8_BAR;
    for (;;) {
        const bool has_next = S.next(ui + 1, nxt);
        if constexpr (GATHER) { if (has_next) { PG8_GVOFF(nxt, vN); } }
        const char* nA = has_next ? nxt.a : cA; const char* nB = has_next ? nxt.b : cB;
        for (int t = 0; t < nt; t += 2) {
            const bool last = (t == nt - 2);
            const char* a1 = cA + (size_t)(t + 1) * kstep;
            const char* a2 = last ? nA : cA + (size_t)(t + 2) * kstep; const char* b2 = last ? nB : cB + (size_t)(t + 2) * kstep;
            const char* a3 = a2 + kstep; const char* b3 = b2 + kstep;
            unsigned v2[2][2];
#pragma unroll
            for (int h = 0; h < 2; ++h)
#pragma unroll
                for (int i = 0; i < 2; ++i) v2[h][i] = (GATHER && last) ? vN[h][i] : vA[GATHER ? h : 0][i];
            PG8_LDB(B0, 0, 0); PG8_LDB(B1, 0, 1); PG8_SCHED; PG8_LDA(At, 0, 0); PG8_STAGE(PG8_SA(1, 1), a1 + hA, vA[GATHER ? 1 : 0]);
            PG8_WAIT_V(8); PG8_WAIT_L(0); PG8_BAR; PG8_MMA(0, 0, At, B0); PG8_MMA(0, 1, At, B1); PG8_BAR; PG8_SCHED;
            PG8_LDA(At, 0, 1); PG8_STAGE(PG8_SB(0, 0), b2, voffB); PG8_STAGE(PG8_SB(0, 1), b2 + hstep, voffB); PG8_STAGE(PG8_SA(0, 0), a2, v2[0]);
            PG8_WAIT_V(8); PG8_WAIT_L(0); PG8_BAR; PG8_MMA(1, 0, At, B0); PG8_MMA(1, 1, At, B1); PG8_BAR; PG8_SCHED;
            PG8_LDB(B0, 1, 0); PG8_LDB(B1, 1, 1); PG8_SCHED; PG8_LDA(At, 1, 0); PG8_STAGE(PG8_SA(0, 1), a2 + hA, v2[1]);
            PG8_WAIT_V(8); PG8_WAIT_L(0); PG8_BAR; PG8_MMA(0, 0, At, B0); PG8_MMA(0, 1, At, B1); PG8_BAR; PG8_SCHED;
            PG8_LDA(At, 1, 1); PG8_STAGE(PG8_SB(1, 0), b3, voffB); PG8_STAGE(PG8_SB(1, 1), b3 + hstep, voffB); PG8_STAGE(PG8_SA(1, 0), a3, v2[0]);
            PG8_WAIT_V(8); PG8_WAIT_L(0); PG8_BAR; PG8_MMA(1, 0, At, B0); PG8_MMA(1, 1, At, B1); PG8_BAR; PG8_SCHED;
        }
        if (wr == 0) PG8_BAR;
        E(acc, cur, wr, wc, fr, fq);
        if (!has_next) break;
#pragma unroll
        for (int a = 0; a < 2; ++a)
#pragma unroll
            for (int b = 0; b < 2; ++b)
#pragma unroll
                for (int m = 0; m < 4; ++m)
#pragma unroll
                    for (int n = 0; n < 2; ++n) acc[a][b][m][n] = (f32x4){0.f, 0.f, 0.f, 0.f};
        cur = nxt; cA = nA; cB = nB; ++ui;
        if constexpr (GATHER) {
#pragma unroll
            for (int h = 0; h < 2; ++h)
#pragma unroll
                for (int i = 0; i < 2; ++i) vA[h][i] = vN[h][i];
        }
        if (wr == 1) PG8_BAR;
    }
    PG8_WAIT_V(0);
    PG8_BAR;
#undef PG8_SA
#undef PG8_SB
#undef PG8_STAGE
#undef PG8_LDA
#undef PG8_LDB
#undef PG8_MMA
#undef PG8_WAIT_V
#undef PG8_WAIT_L
#undef PG8_BAR
#undef PG8_SCHED
#undef PG8_GVOFF
}

struct EpiProj {
    static constexpr bool PERM = true;
    bf16_t* O; const LAS float* gtab;
    __device__ __forceinline__ void operator()(const Acc& acc, const Unit& u, int wr, int wc, int fr, int fq) const {
        const int mode = u.mode;
        f32x4 g[2][2];
#pragma unroll
        for (int bj = 0; bj < 2; ++bj)
#pragma unroll
            for (int n = 0; n < 2; ++n) g[bj][n] = (mode == 1 || mode == 2) ? *(const LAS f32x4*)(gtab + (mode - 1) * 64 + 32 * bj + 8 * fq + 4 * n) : (f32x4){1.f, 1.f, 1.f, 1.f};
        const float sc = (mode == 3) ? C2 : 1.f;
#pragma unroll
        for (int ai = 0; ai < 2; ++ai)
#pragma unroll
            for (int m = 0; m < 4; ++m) {
                const int row = u.row0 + ai * HALF + wr * 64 + m * 16 + fr;
                float rs = sc;
                if (mode == 1 || mode == 2) {
                    float ss = 0.f;
#pragma unroll
                    for (int bj = 0; bj < 2; ++bj)
#pragma unroll
                        for (int n = 0; n < 2; ++n) { const f32x4 v = acc[ai][bj][m][n]; ss += (v[0] * v[0] + v[1] * v[1]) + (v[2] * v[2] + v[3] * v[3]); }
                    ss += xor_swz<16>(ss); ss = xor32_sum(ss);
                    rs = __builtin_amdgcn_rsqf(ss * (1.f / 64.f) + EPS);
                }
                bf16_t* rowp = O + (size_t)row * NQKV + u.col0 + 64 * wc + 8 * fq;
#pragma unroll
                for (int bj = 0; bj < 2; ++bj) {
                    const f32x4 v0 = acc[ai][bj][m][0] * rs * g[bj][0], v1 = acc[ai][bj][m][1] * rs * g[bj][1];
                    u32x4 w; w.x = cvt_pk_bf16(v0[0], v0[1]); w.y = cvt_pk_bf16(v0[2], v0[3]); w.z = cvt_pk_bf16(v1[0], v1[1]); w.w = cvt_pk_bf16(v1[2], v1[3]);
                    *(u32x4*)(rowp + 32 * bj) = w;
                }
            }
    }
};
struct EpiResid {
    static constexpr bool PERM = false;
    float* X;
    __device__ __forceinline__ void operator()(const Acc& acc, const Unit& u, int wr, int wc, int fr, int fq) const {
#pragma unroll
        for (int ai = 0; ai < 2; ++ai)
#pragma unroll
            for (int m = 0; m < 4; ++m) {
                float* rowp = X + (size_t)(u.row0 + ai * HALF + wr * 64 + m * 16 + fr) * DM + u.col0 + wc * 32 + 4 * fq;
#pragma unroll
                for (int bj = 0; bj < 2; ++bj)
#pragma unroll
                    for (int n = 0; n < 2; ++n) { f32x4* p = (f32x4*)(rowp + bj * HALF + n * 16); *p = *p + acc[ai][bj][m][n]; }
                if (m & 1) asm volatile("" ::: "memory");
            }
    }
};
struct EpiSwiGLU {
    static constexpr bool PERM = true;
    bf16_t* Hb;
    __device__ __forceinline__ void operator()(const Acc& acc, const Unit& u, int wr, int wc, int fr, int fq) const {
#pragma unroll
        for (int ai = 0; ai < 2; ++ai)
#pragma unroll
            for (int m = 0; m < 4; ++m) {
                bf16_t* rowp = Hb + (size_t)(u.row0 + ai * HALF + wr * 64 + m * 16 + fr) * DM + u.col0 + wc * 32 + 8 * fq;
                float r[8];
#pragma unroll
                for (int n = 0; n < 2; ++n)
#pragma unroll
                    for (int i = 0; i < 4; ++i) { const float gt = acc[ai][0][m][n][i], up = acc[ai][1][m][n][i];
                        r[4 * n + i] = gt * __builtin_amdgcn_rcpf(1.f + __builtin_amdgcn_exp2f(-gt * LOG2E)) * up; }
                u32x4 w; w.x = cvt_pk_bf16(r[0], r[1]); w.y = cvt_pk_bf16(r[2], r[3]); w.z = cvt_pk_bf16(r[4], r[5]); w.w = cvt_pk_bf16(r[6], r[7]);
                *(u32x4*)rowp = w;
            }
    }
};
struct EpiBf16 {
    static constexpr bool PERM = true;
    bf16_t* Yb;
    __device__ __forceinline__ void operator()(const Acc& acc, const Unit& u, int wr, int wc, int fr, int fq) const {
#pragma unroll
        for (int ai = 0; ai < 2; ++ai)
#pragma unroll
            for (int m = 0; m < 4; ++m) {
                bf16_t* rowp = Yb + (size_t)(u.row0 + ai * HALF + wr * 64 + m * 16 + fr) * DM + u.col0 + wc * 32 + 8 * fq;
#pragma unroll
                for (int bj = 0; bj < 2; ++bj) { const f32x4 v0 = acc[ai][bj][m][0], v1 = acc[ai][bj][m][1];
                    u32x4 w; w.x = cvt_pk_bf16(v0[0], v0[1]); w.y = cvt_pk_bf16(v0[2], v0[3]); w.z = cvt_pk_bf16(v1[0], v1[1]); w.w = cvt_pk_bf16(v1[2], v1[3]);
                    *(u32x4*)(rowp + bj * HALF) = w; }
            }
    }
};

struct ProjSched {
    StaticOrder so; const char* A; const char* W; int mq, mk, s_lo, s_hi;
    __device__ bool next(int i, Unit& u) const { int pm, pn; if (!so.next(i, pm, pn)) return false;
        u.a = A + (size_t)pm * BM * K * 2; u.b = W + (size_t)pn * BM * K * 2; u.list = nullptr; u.nvalid = 0; u.row0 = pm * BM; u.col0 = pn * BM;
        u.mode = pn < mq ? 1 : (pn < mk ? 2 : ((pn >= s_lo && pn < s_hi) ? 3 : 0)); return true; }
};
struct WoutSched {
    StaticOrder so; const char* A; const char* W;
    __device__ bool next(int i, Unit& u) const { int pm, pn; if (!so.next(i, pm, pn)) return false;
        u.a = A + (size_t)pm * BM * K * 2; u.b = W + (size_t)pn * BM * K * 2; u.list = nullptr; u.nvalid = 0; u.row0 = pm * BM; u.col0 = pn * BM; u.mode = 0; return true; }
};
template <int NT, bool UP> struct MoeSched {
    const LAS int* tab;
    int G, c; const char* A; const char* W; const int* lists;
    __device__ bool next(int i, Unit& u) const {
        const int total = tab[16];
        const long L = (long)i * G + c; if (L >= (long)total * NT) return false;
        const int rt = (int)(L / NT), pn = (int)(L % NT);
        int e = 0;
#pragma unroll
        for (int j = 1; j < 16; ++j) e += (rt >= tab[j]) ? 1 : 0;
        e = __builtin_amdgcn_readfirstlane(e);
        const int r0 = __builtin_amdgcn_readfirstlane(tab[e]), ce = __builtin_amdgcn_readfirstlane(tab[17 + e]);
        const int rel0 = (rt - r0) * BM;
        if (UP) { u.a = A; u.b = W + ((size_t)e * 2048 + (size_t)pn * BM) * K * 2; u.list = lists + e * LISTCAP + rel0; u.nvalid = ce - rel0; u.col0 = pn * 128; }
        else    { u.a = A + (size_t)rt * BM * K * 2; u.b = W + ((size_t)e * 1024 + (size_t)pn * BM) * K * 2; u.list = nullptr; u.nvalid = 0; u.col0 = pn * BM; }
        u.row0 = rt * BM; u.mode = 0; return true;
    }
};
}

namespace att {
using bf16 = __hip_bfloat16;
constexpr int NW = 8, QBLK = 32, QB = QBLK * NW, KVBLK = 64;
constexpr int NSLOT = 3, SLOTB = 8192;
constexpr int LDS_K = 0, LDS_V = NSLOT * SLOTB, LDS_WS = 2 * NSLOT * SLOTB, LDS_OST = LDS_WS + NW * 64 * 4, LDS_END = LDS_OST + NW * 4096;
constexpr int LDS_FTAB = 86016;
static_assert(LDS_END <= LDS_FTAB && LDS_FTAB + 32768 <= RING_BYTES, "attention LDS map");
__device__ __forceinline__ int crow(int r, int hi) { return (r & 3) + 8 * (r >> 2) + 4 * hi; }
#define SBAR() __builtin_amdgcn_sched_barrier(0)
__device__ __forceinline__ void glds16(const void* gsrc, unsigned lds_dst) { unsigned keep;
  asm volatile("s_mov_b32 %0, m0\n\ts_mov_b32 m0, %2\n\ts_nop 0\n\tglobal_load_lds_dwordx4 %1, off\n\ts_mov_b32 m0, %0" : "=&s"(keep) : "v"(gsrc), "s"(lds_dst) : "memory"); }
typedef __bf16 bf16x2_t __attribute__((ext_vector_type(2)));
__device__ __forceinline__ unsigned cvtpk_s(float lo, float hi) { f32x2 v = {lo, hi}; bf16x2_t b = __builtin_convertvector(v, bf16x2_t); return __builtin_bit_cast(unsigned, b); }
#define WAIT_BAR(N) asm volatile("s_waitcnt vmcnt(" #N ") lgkmcnt(0)\n\ts_barrier" ::: "memory")
typedef LAS const char* lds_cptr;
typedef short v4i16_t __attribute__((ext_vector_type(4)));

__device__ __forceinline__ void qkt_acc(f32x16& p0, f32x16& p1, const char* Kslot, const bf16x8* qr, int r32, int hi) {
  const char* kb = Kslot + hi * 1024 + r32 * 16;
#pragma unroll
  for (int d0 = 0; d0 < 4; ++d0) {
    const bf16x8 b0 = *reinterpret_cast<const bf16x8*>(kb + d0 * 2048);
    const bf16x8 b1 = *reinterpret_cast<const bf16x8*>(kb + d0 * 2048 + 512);
    p0 = __builtin_amdgcn_mfma_f32_32x32x16_bf16(b0, qr[d0], p0, 0, 0, 0); p1 = __builtin_amdgcn_mfma_f32_32x32x16_bf16(b1, qr[d0], p1, 0, 0, 0); }
}
__device__ __forceinline__ void kload8(bf16x8* kf, lds_cptr kp) {
  kf[0] = *(const LAS bf16x8*)(kp);        kf[1] = *(const LAS bf16x8*)(kp + 512);
  kf[2] = *(const LAS bf16x8*)(kp + 2048); kf[3] = *(const LAS bf16x8*)(kp + 2560);
  kf[4] = *(const LAS bf16x8*)(kp + 4096); kf[5] = *(const LAS bf16x8*)(kp + 4608);
  kf[6] = *(const LAS bf16x8*)(kp + 6144); kf[7] = *(const LAS bf16x8*)(kp + 6656);
}
__device__ __forceinline__ void kload2(bf16x8* kf, lds_cptr kp, int j) { kf[2 * j] = *(const LAS bf16x8*)(kp + j * 2048); kf[2 * j + 1] = *(const LAS bf16x8*)(kp + j * 2048 + 512); }
__device__ __forceinline__ s16x4 vtr(lds_cptr p) { return __builtin_bit_cast(s16x4, __builtin_amdgcn_ds_read_tr16_b64_v4i16((LAS v4i16_t*)p)); }
__device__ __forceinline__ void pv(f32x16* o, int vb, bf16x8 pa0, bf16x8 pa1, bf16x8 pa2, bf16x8 pa3) {
#pragma unroll
  for (int d0 = 0; d0 < 2; ++d0) { s16x4 lo[4], hi[4];
#pragma unroll
    for (int ks = 0; ks < 4; ++ks) {
      asm volatile("ds_read_b64_tr_b16 %0,%1 offset:%c2" : "=&v"(lo[ks]) : "v"(vb), "i"(d0 * 4096 + ks * 1024) : "memory");
      asm volatile("ds_read_b64_tr_b16 %0,%1 offset:%c2" : "=&v"(hi[ks]) : "v"(vb), "i"(d0 * 4096 + ks * 1024 + 512) : "memory"); }
    asm volatile("s_waitcnt lgkmcnt(0)" ::: "memory"); SBAR();
#define PK(k) (bf16x8){lo[k][0], lo[k][1], lo[k][2], lo[k][3], hi[k][0], hi[k][1], hi[k][2], hi[k][3]}
    o[d0] = __builtin_amdgcn_mfma_f32_32x32x16_bf16(pa0, PK(0), o[d0], 0, 0, 0);
    o[d0] = __builtin_amdgcn_mfma_f32_32x32x16_bf16(pa1, PK(1), o[d0], 0, 0, 0);
    o[d0] = __builtin_amdgcn_mfma_f32_32x32x16_bf16(pa2, PK(2), o[d0], 0, 0, 0);
    o[d0] = __builtin_amdgcn_mfma_f32_32x32x16_bf16(pa3, PK(3), o[d0], 0, 0, 0);
#undef PK
  }
}
template <int PO> __device__ __forceinline__ void store_o(const f32x16* o, const float* rs, bf16* Ow, char* shm, int wid, int lane, int r32, int hi) {
  bf16* stg = (bf16*)(shm + LDS_OST) + wid * 2048;
#pragma unroll
  for (int r = 0; r < 16; ++r) { const int orow = crow(r, hi);
#pragma unroll
    for (int d0 = 0; d0 < 2; ++d0) stg[orow * 64 + d0 * 32 + r32] = __float2bfloat16(o[d0][r] * rs[r]); }
  asm volatile("s_waitcnt lgkmcnt(0)" ::: "memory");
#pragma unroll
  for (int i = 0; i < 4; ++i) { const int row = i * 8 + (lane >> 3), ch = lane & 7; const u32x4 v = *(const u32x4*)(stg + row * 64 + ch * 8); *(u32x4*)(Ow + (long)row * PO + ch * 8) = v; }
}

template <int PO> __device__ __forceinline__ void attn_unit_b(int qb, int js, const bf16* Qh, const bf16* __restrict__ Kh, const bf16* __restrict__ Vh, bf16* Oh, float Bp, char* shm, const int tid) {
  const int lane = tid & 63, r32 = lane & 31, hi = lane >> 5; const int wid = __builtin_amdgcn_readfirstlane(tid >> 6);
  const int q0 = qb * QB;
  const bf16* Qw = Qh + (long)(q0 + wid * QBLK) * PQ;
  const unsigned lds0 = (unsigned)(uintptr_t)shm;
  float* wsf = (float*)(shm + LDS_WS) + wid * 64;
  const bf16* ksrc = Kh + (long)(js * KVBLK + lane) * PQ + wid * 8;
  const bf16* vsrc = Vh + (long)(js * KVBLK + 16 * (wid & 3) + (lane >> 2)) * PQ + (wid >> 2) * 32 + (lane & 3) * 8;
  const unsigned kdst = lds0 + LDS_K + wid * 1024, vdst = lds0 + LDS_V + wid * 1024;
#define DMA_K(t, slot) glds16(ksrc + (long)(t) * KVBLK * PQ, (unsigned)__builtin_amdgcn_readfirstlane(kdst + (slot)))
#define DMA_V(t, slot) glds16(vsrc + (long)(t) * KVBLK * PQ, (unsigned)__builtin_amdgcn_readfirstlane(vdst + (slot)))
  const int vb0 = (int)(lds0 + LDS_V) + ((lane >> 4) & 1) * 32 + (lane & 3) * 8 + (4 * hi + ((lane & 15) >> 2)) * 64;
  const char* Kbase = shm + LDS_K; bf16x8 kf[8];
  const lds_cptr shm3 = (lds_cptr)shm; const lds_cptr kp0 = shm3 + LDS_K + hi * 1024 + r32 * 16; const lds_cptr vp0 = shm3 + LDS_V + ((lane >> 4) & 1) * 32 + (lane & 3) * 8 + (4 * hi + ((lane & 15) >> 2)) * 64;
  const LAS float* ftab = (const LAS float*)(shm3 + LDS_FTAB);
  const int NT = (q0 + QB) / KVBLK - js;
  DMA_K(0, 0); DMA_V(0, 0); DMA_K(1, SLOTB);
  bf16x8 qr[4];
#pragma unroll
  for (int d0 = 0; d0 < 4; ++d0) qr[d0] = *reinterpret_cast<const bf16x8*>(&Qw[(long)r32 * PQ + d0 * 16 + hi * 8]);
  float l_reg = 0.f; f32x16 o[2]; o[0] = f32x16{}; o[1] = f32x16{};
  const int qrel = wid * QBLK + r32;
  const float rc = ftab[q0 + qrel] - Bp;
  const LAS float* fth = ftab + 64 * js + 4 * hi;
#define CMASK(P0, P1, t) do { const int jb_ = (t) - (NT - 4); if (jb_ >= 0) { const int kb_ = 64 * jb_ + 4 * hi; \
    _Pragma("unroll") for (int r = 0; r < 16; ++r) { const int kv_ = kb_ + (r & 3) + 8 * (r >> 2); if (kv_ > qrel) P0[r] = -INFINITY; if (kv_ + 32 > qrel) P1[r] = -INFINITY; } } } while (0)
#define CMASK0(P0, t) do { const int jb_ = (t) - (NT - 4); if (jb_ >= 0) { const int kb_ = 64 * jb_ + 4 * hi; \
    _Pragma("unroll") for (int r = 0; r < 16; ++r) { const int kv_ = kb_ + (r & 3) + 8 * (r >> 2); if (kv_ > qrel) P0[r] = -INFINITY; } } } while (0)
#define CMASK1(P1, t) do { const int jb_ = (t) - (NT - 4); if (jb_ >= 0) { const int kb_ = 64 * jb_ + 4 * hi; \
    _Pragma("unroll") for (int r = 0; r < 16; ++r) { const int kv_ = kb_ + (r & 3) + 8 * (r >> 2); if (kv_ + 32 > qrel) P1[r] = -INFINITY; } } } while (0)
#define BIASG(P, t, ph, g) do { const f32x4 f_ = *(const LAS f32x4*)(fth + 64 * (t) + 32 * (ph) + 8 * (g)); \
    P[4 * (g)] = rc - f_[0]; P[4 * (g) + 1] = rc - f_[1]; P[4 * (g) + 2] = rc - f_[2]; P[4 * (g) + 3] = rc - f_[3]; } while (0)
#define BIAS_FULL(P0, P1, t) do { BIASG(P0, t, 0, 0); BIASG(P0, t, 0, 1); BIASG(P0, t, 0, 2); BIASG(P0, t, 0, 3); BIASG(P1, t, 1, 0); BIASG(P1, t, 1, 1); BIASG(P1, t, 1, 2); BIASG(P1, t, 1, 3); } while (0)
  f32x16 rcv;
#pragma unroll
  for (int r = 0; r < 16; ++r) rcv[r] = rc;
  asm volatile("" : "+v"(rcv));
  f32x16 pA0, pA1, pB0, pB1;
  BIAS_FULL(pA0, pA1, 0);
  int sl_prev = 0, sl_cur = 0, sl_next = SLOTB;
#define ROT() do { sl_prev = sl_cur; sl_cur = sl_next; sl_next = (sl_next == (NSLOT - 1) * SLOTB) ? 0 : sl_next + SLOTB; } while (0)
  DMA_K(2, 2 * SLOTB);
  WAIT_BAR(3);
  qkt_acc(pA0, pA1, Kbase, qr, r32, hi); CMASK(pA0, pA1, 0);
#pragma unroll
  for (int r = 0; r < 16; ++r) { pA0[r] = __builtin_amdgcn_exp2f(pA0[r]); pA1[r] = __builtin_amdgcn_exp2f(pA1[r]); }
  WAIT_BAR(0);
  DMA_K(3, 0); DMA_V(1, SLOTB);
  ROT();
  kload8(kf, kp0 + sl_cur);
  WAIT_BAR(2);
  s16x4 vlo[8], vhi[8]; u32x4 pw0, pw1, pw2, pw3;
#define PKW(P, B) cvtpk_s(P[B], P[B + 1])
#define PAF(k) __builtin_bit_cast(bf16x8, pw##k)
#define VFR(i) (bf16x8){vlo[i][0], vlo[i][1], vlo[i][2], vlo[i][3], vhi[i][0], vhi[i][1], vhi[i][2], vhi[i][3]}
#define PIN(x) asm volatile("" : "+v"(x))
#define GAPA(MF, A0, A1, A2, A3, W0, W1, PW) do { MF; sacc += A0; sacc += A1; sacc += A2; sacc += A3; PIN(sacc); W0; W1; PIN(PW); SBAR(); } while (0)
#define EX(v) __builtin_amdgcn_exp2f(v)
#define GAPB(MF, X, B) do { MF; X[B] = EX(X[B]); X[B + 1] = EX(X[B + 1]); X[B + 2] = EX(X[B + 2]); X[B + 3] = EX(X[B + 3]); PIN(X); SBAR(); } while (0)
#define GAPB2(MF, X, B, Y, F, B2) do { MF; X[B] = EX(X[B]); X[B + 1] = EX(X[B + 1]); X[B + 2] = EX(X[B + 2]); X[B + 3] = EX(X[B + 3]); PIN(X); \
    Y[B2] -= F[B2]; Y[B2 + 1] -= F[B2 + 1]; Y[B2 + 2] -= F[B2 + 2]; Y[B2 + 3] -= F[B2 + 3]; PIN(Y); SBAR(); } while (0)
#define FLD(P, t, ph, g) do { const f32x4 f_ = *(const LAS f32x4*)(fth + 64 * (t) + 32 * (ph) + 8 * (g)); P[4 * (g)] = f_[0]; P[4 * (g) + 1] = f_[1]; P[4 * (g) + 2] = f_[2]; P[4 * (g) + 3] = f_[3]; } while (0)
#define VRD(i) do { vlo[i] = vtr(vp_ + (((i) >> 2) * 4096 + ((i) & 3) * 1024)); vhi[i] = vtr(vp_ + (((i) >> 2) * 4096 + ((i) & 3) * 1024 + 512)); } while (0)
#define KRD(G, j) do { if (G) { kload2(kf, kp0 + sl_next, j); SBAR(); } } while (0)
#define MF32(a, b, c) __builtin_amdgcn_mfma_f32_32x32x16_bf16(a, b, c, 0, 0, 0)
#define STEP(C0, C1, P0, P1, t, GK, GV, GL) do { SBAR(); \
    const lds_cptr vp_ = vp0 + sl_prev; \
    VRD(0); SBAR(); float sacc = (P0[0] + P0[1]); \
    GAPA(C0 = MF32(kf[0], qr[0], rcv), P0[2], P0[3], P0[4], P0[5],     pw0[0] = PKW(P0, 0), pw0[1] = PKW(P0, 2), pw0); \
    VRD(4); SBAR(); GAPA(C1 = MF32(kf[1], qr[0], rcv), P0[6], P0[7], P0[8], P0[9],     pw0[2] = PKW(P0, 4), pw0[3] = PKW(P0, 6), pw0); \
    VRD(1); SBAR(); GAPA(C0 = MF32(kf[2], qr[1], C0), P0[10], P0[11], P0[12], P0[13], pw1[0] = PKW(P0, 8), pw1[1] = PKW(P0, 10), pw1); \
    VRD(5); SBAR(); GAPA(C1 = MF32(kf[3], qr[1], C1), P0[14], P0[15], P1[0], P1[1],   pw1[2] = PKW(P0, 12), pw1[3] = PKW(P0, 14), pw1); \
    VRD(2); FLD(P0, t, 0, 0); SBAR(); GAPA(C0 = MF32(kf[4], qr[2], C0), P1[2], P1[3], P1[4], P1[5],     pw2[0] = PKW(P1, 0), pw2[1] = PKW(P1, 2), pw2); \
    VRD(6); FLD(P0, t, 0, 1); SBAR(); GAPA(C1 = MF32(kf[5], qr[2], C1), P1[6], P1[7], P1[8], P1[9],     pw2[2] = PKW(P1, 4), pw2[3] = PKW(P1, 6), pw2); \
    VRD(3); FLD(P0, t, 0, 2); SBAR(); GAPA(C0 = MF32(kf[6], qr[3], C0), P1[10], P1[11], P1[12], P1[13], pw3[0] = PKW(P1, 8), pw3[1] = PKW(P1, 10), pw3); \
    VRD(7); FLD(P0, t, 0, 3); SBAR(); GAPA(C1 = MF32(kf[7], qr[3], C1), P1[14], P1[15], 0.f, 0.f,       pw3[2] = PKW(P1, 12), pw3[3] = PKW(P1, 14), pw3); \
    l_reg += sacc; \
    if (GK) { DMA_K((t) + 3, sl_cur); } if (GV) { DMA_V((t) + 1, sl_next); } \
    FLD(P1, t, 1, 0); FLD(P1, t, 1, 1); FLD(P1, t, 1, 2); FLD(P1, t, 1, 3); \
    _Pragma("unroll") for (int r = 0; r < 16; ++r) C0[r] -= P0[r]; \
    _Pragma("unroll") for (int r = 0; r < 16; ++r) C1[r] -= P1[r]; \
    CMASK(C0, C1, t); \
    SBAR(); \
    GAPB(o[0] = MF32(PAF(0), VFR(0), o[0]), C0, 0); \
    GAPB(o[1] = MF32(PAF(0), VFR(4), o[1]), C0, 4); \
    KRD(GL, 0); GAPB(o[0] = MF32(PAF(1), VFR(1), o[0]), C0, 8); \
    KRD(GL, 1); GAPB(o[1] = MF32(PAF(1), VFR(5), o[1]), C0, 12); \
    KRD(GL, 2); GAPB(o[0] = MF32(PAF(2), VFR(2), o[0]), C1, 0); \
    KRD(GL, 3); GAPB(o[1] = MF32(PAF(2), VFR(6), o[1]), C1, 4); \
    GAPB(o[0] = MF32(PAF(3), VFR(3), o[0]), C1, 8); \
    GAPB(o[1] = MF32(PAF(3), VFR(7), o[1]), C1, 12); \
    } while (0)
  int t = 1;
#undef CMASK
#undef CMASK0
#undef CMASK1
#define CMASK(P0, P1, t) do { } while (0)
#define CMASK0(P0, t) do { } while (0)
#define CMASK1(P1, t) do { } while (0)
  for (; t + 5 < NT; t += 2) {
    STEP(pB0, pB1, pA0, pA1, t, true, true, true);     WAIT_BAR(2); ROT();
    STEP(pA0, pA1, pB0, pB1, t + 1, true, true, true); WAIT_BAR(2); ROT();
  }
#undef CMASK
#undef CMASK0
#undef CMASK1
#define CMASK(P0, P1, t) do { const int jb_ = (t) - (NT - 4); if (jb_ >= 0) { const int kb_ = 64 * jb_ + 4 * hi; \
    _Pragma("unroll") for (int r = 0; r < 16; ++r) { const int kv_ = kb_ + (r & 3) + 8 * (r >> 2); if (kv_ > qrel) P0[r] = -INFINITY; if (kv_ + 32 > qrel) P1[r] = -INFINITY; } } } while (0)
#define CMASK0(P0, t) do { const int jb_ = (t) - (NT - 4); if (jb_ >= 0) { const int kb_ = 64 * jb_ + 4 * hi; \
    _Pragma("unroll") for (int r = 0; r < 16; ++r) { const int kv_ = kb_ + (r & 3) + 8 * (r >> 2); if (kv_ > qrel) P0[r] = -INFINITY; } } } while (0)
#define CMASK1(P1, t) do { const int jb_ = (t) - (NT - 4); if (jb_ >= 0) { const int kb_ = 64 * jb_ + 4 * hi; \
    _Pragma("unroll") for (int r = 0; r < 16; ++r) { const int kv_ = kb_ + (r & 3) + 8 * (r >> 2); if (kv_ + 32 > qrel) P1[r] = -INFINITY; } } } while (0)
#define ENDW(tt) do { if ((tt) + 3 < NT) { WAIT_BAR(2); } else if ((tt) + 2 < NT) { WAIT_BAR(1); } else { WAIT_BAR(0); } } while (0)
  for (; t + 1 < NT; t += 2) {
    STEP(pB0, pB1, pA0, pA1, t, (t + 3 < NT), (t + 1 < NT), (t + 1 < NT));         ENDW(t);     ROT();
    STEP(pA0, pA1, pB0, pB1, t + 1, (t + 4 < NT), (t + 2 < NT), (t + 2 < NT));     ENDW(t + 1); ROT();
  }
  STEP(pB0, pB1, pA0, pA1, NT - 1, false, false, false);
  { float sacc = pB0[0] + pB0[1];
#pragma unroll
    for (int r = 2; r < 16; ++r) sacc += pB0[r];
#pragma unroll
    for (int r = 0; r < 16; ++r) sacc += pB1[r];
    l_reg += sacc;
    pw0 = (u32x4){PKW(pB0, 0), PKW(pB0, 2), PKW(pB0, 4), PKW(pB0, 6)}; pw1 = (u32x4){PKW(pB0, 8), PKW(pB0, 10), PKW(pB0, 12), PKW(pB0, 14)};
    pw2 = (u32x4){PKW(pB1, 0), PKW(pB1, 2), PKW(pB1, 4), PKW(pB1, 6)}; pw3 = (u32x4){PKW(pB1, 8), PKW(pB1, 10), PKW(pB1, 12), PKW(pB1, 14)};
    SBAR(); pv(o, vb0 + sl_cur, PAF(0), PAF(1), PAF(2), PAF(3)); }
#undef PKW
#undef PAF
#undef VFR
#undef PIN
#undef GAPA
#undef GAPB
#undef GAPB2
#undef FLD
#undef EX
#undef VRD
#undef KRD
#undef STEP
#undef ENDW
#undef MF32
  { auto rr = __builtin_amdgcn_permlane32_swap(__float_as_uint(l_reg), __float_as_uint(l_reg), false, false); l_reg = __uint_as_float(rr[0]) + __uint_as_float(rr[1]); }
  int lane_e; asm volatile("v_mbcnt_lo_u32_b32 %0, -1, 0\n\tv_mbcnt_hi_u32_b32 %0, -1, %0" : "=&v"(lane_e));
  const int r32e = lane_e & 31, hie = lane_e >> 5;
  if (hie == 0) wsf[32 + r32e] = l_reg; asm volatile("s_waitcnt lgkmcnt(0)" ::: "memory");
  float rli[16];
#pragma unroll
  for (int r = 0; r < 16; ++r) rli[r] = __builtin_amdgcn_rcpf(wsf[32 + crow(r, hie)]);
  store_o<PO>(o, rli, Oh + (long)(q0 + wid * QBLK) * PO, shm, wid, lane_e, r32e, hie);
  asm volatile("s_waitcnt lgkmcnt(0)\n\ts_barrier" ::: "memory");
#undef DMA_K
#undef DMA_V
#undef CMASK
#undef CMASK0
#undef CMASK1
#undef BIASG
#undef BIAS_FULL
#undef ROT
}

template <int PO> __device__ __forceinline__ void sb_unit(int qb, const bf16* Qh, const bf16* __restrict__ Kh, const bf16* __restrict__ Vh, bf16* Oh, char* shm, const int tid) {
  const int lane = tid & 63, r32 = lane & 31, hi = lane >> 5; const int wid = __builtin_amdgcn_readfirstlane(tid >> 6);
  const int q0 = qb * QB;
  const bf16* Qw = Qh + (long)(q0 + wid * QBLK) * PQ;
  const unsigned lds0 = (unsigned)(uintptr_t)shm;
  const bf16* ksrc = Kh + (long)lane * PQ + wid * 8;
  const bf16* vsrc = Vh + (long)(16 * (wid & 3) + (lane >> 2)) * PQ + (wid >> 2) * 32 + (lane & 3) * 8;
  const unsigned kdst = lds0 + LDS_K + wid * 1024, vdst = lds0 + LDS_V + wid * 1024;
#define DMA_K(t, slot) glds16(ksrc + (long)(t) * KVBLK * PQ, (unsigned)__builtin_amdgcn_readfirstlane(kdst + (slot)))
#define DMA_V(t, slot) glds16(vsrc + (long)(t) * KVBLK * PQ, (unsigned)__builtin_amdgcn_readfirstlane(vdst + (slot)))
  const int vb0 = (int)(lds0 + LDS_V) + ((lane >> 4) & 1) * 32 + (lane & 3) * 8 + (4 * hi + ((lane & 15) >> 2)) * 64;
  volatile LAS unsigned* flags = (volatile LAS unsigned*)((LAS char*)shm + LDS_WS);
  bf16x8 qr[4];
#pragma unroll
  for (int d0 = 0; d0 < 4; ++d0) qr[d0] = *reinterpret_cast<const bf16x8*>(&Qw[(long)r32 * PQ + d0 * 16 + hi * 8]);
  f32x16 o[2]; o[0] = f32x16{}; o[1] = f32x16{};
  const int qrel = wid * QBLK + r32;
  float arun = 0.f;
  const int jt = 4 * qb + 3;
  DMA_K(jt, 0); DMA_V(jt, 0);
  int slot = 0;
  for (int it = 0;; ++it) {
    const int tile = jt - it;
    const bool has_next = tile > 0;
    if (has_next) { DMA_K(tile - 1, (slot ^ 1) * SLOTB); DMA_V(tile - 1, (slot ^ 1) * SLOTB); WAIT_BAR(2); } else { WAIT_BAR(0); }
    const int jb = tile - 4 * qb;
    const bool active = (jb < 0) || (64 * jb < 32 * wid + 31);
    if (active) {
      f32x16 z0 = f32x16{}, z1 = f32x16{};
      qkt_acc(z0, z1, shm + LDS_K + slot * SLOTB, qr, r32, hi);
      if (jb >= 0) { const int kb = 64 * jb + 4 * hi;
#pragma unroll
        for (int r = 0; r < 16; ++r) { const int kv = kb + (r & 3) + 8 * (r >> 2); if (kv >= qrel) z0[r] = -INFINITY; if (kv + 32 >= qrel) z1[r] = -INFINITY; } }
      f32x16 k0, k1;
#pragma unroll
      for (int r = 0; r < 16; ++r) {
        { const float z = z0[r]; const float e = __builtin_amdgcn_exp2f(-__builtin_fabsf(z)); k0[r] = -(fmaxf(z, 0.f) + __builtin_amdgcn_logf(1.f + e)); }
        { const float z = z1[r]; const float e = __builtin_amdgcn_exp2f(-__builtin_fabsf(z)); k1[r] = -(fmaxf(z, 0.f) + __builtin_amdgcn_logf(1.f + e)); } }
      float s[2][4], ps[2][4];
#pragma unroll
      for (int g = 0; g < 4; ++g) { s[0][g] = (k0[4 * g] + k0[4 * g + 1]) + (k0[4 * g + 2] + k0[4 * g + 3]); s[1][g] = (k1[4 * g] + k1[4 * g + 1]) + (k1[4 * g + 2] + k1[4 * g + 3]); }
#pragma unroll
      for (int p = 0; p < 2; ++p)
#pragma unroll
        for (int g = 0; g < 4; ++g) ps[p][g] = xor32_partner(s[p][g], hi != 0);
      float suf = 0.f;
      float T[2][4];
#pragma unroll
      for (int p = 1; p >= 0; --p)
#pragma unroll
        for (int g = 3; g >= 0; --g) { T[p][g] = arun + suf + (hi == 0 ? ps[p][g] : 0.f); suf += s[p][g] + ps[p][g]; }
#pragma unroll
      for (int g = 0; g < 4; ++g) {
        { const float a3 = T[0][g], a2 = a3 + k0[4 * g + 3], a1 = a2 + k0[4 * g + 2], a0 = a1 + k0[4 * g + 1];
          z0[4 * g + 3] = __builtin_amdgcn_exp2f(z0[4 * g + 3] + k0[4 * g + 3] + a3); z0[4 * g + 2] = __builtin_amdgcn_exp2f(z0[4 * g + 2] + k0[4 * g + 2] + a2);
          z0[4 * g + 1] = __builtin_amdgcn_exp2f(z0[4 * g + 1] + k0[4 * g + 1] + a1); z0[4 * g]     = __builtin_amdgcn_exp2f(z0[4 * g] + k0[4 * g] + a0); }
        { const float a3 = T[1][g], a2 = a3 + k1[4 * g + 3], a1 = a2 + k1[4 * g + 2], a0 = a1 + k1[4 * g + 1];
          z1[4 * g + 3] = __builtin_amdgcn_exp2f(z1[4 * g + 3] + k1[4 * g + 3] + a3); z1[4 * g + 2] = __builtin_amdgcn_exp2f(z1[4 * g + 2] + k1[4 * g + 2] + a2);
          z1[4 * g + 1] = __builtin_amdgcn_exp2f(z1[4 * g + 1] + k1[4 * g + 1] + a1); z1[4 * g]     = __builtin_amdgcn_exp2f(z1[4 * g] + k1[4 * g] + a0); } }
      arun += suf;
      u32x4 w0, w1, w2, w3;
      w0 = (u32x4){cvtpk_s(z0[0], z0[1]), cvtpk_s(z0[2], z0[3]), cvtpk_s(z0[4], z0[5]), cvtpk_s(z0[6], z0[7])};
      w1 = (u32x4){cvtpk_s(z0[8], z0[9]), cvtpk_s(z0[10], z0[11]), cvtpk_s(z0[12], z0[13]), cvtpk_s(z0[14], z0[15])};
      w2 = (u32x4){cvtpk_s(z1[0], z1[1]), cvtpk_s(z1[2], z1[3]), cvtpk_s(z1[4], z1[5]), cvtpk_s(z1[6], z1[7])};
      w3 = (u32x4){cvtpk_s(z1[8], z1[9]), cvtpk_s(z1[10], z1[11]), cvtpk_s(z1[12], z1[13]), cvtpk_s(z1[14], z1[15])};
      pv(o, vb0 + slot * SLOTB, __builtin_bit_cast(bf16x8, w0), __builtin_bit_cast(bf16x8, w1), __builtin_bit_cast(bf16x8, w2), __builtin_bit_cast(bf16x8, w3));
    }
    const bool done_w = __all(arun < -152.f);
    if (lane == 0) flags[wid] = done_w ? 1u : 0u;
    asm volatile("s_waitcnt lgkmcnt(0)\n\ts_barrier" ::: "memory");
    unsigned alld = 1u;
#pragma unroll
    for (int w = 0; w < NW; ++w) alld &= flags[w];
    alld = __builtin_amdgcn_readfirstlane(alld);
    if (!has_next || alld) break;
    slot ^= 1;
  }
  asm volatile("s_waitcnt vmcnt(0)" ::: "memory");
  float ones[16];
#pragma unroll
  for (int r = 0; r < 16; ++r) ones[r] = 1.f;
  store_o<PO>(o, ones, Oh + (long)(q0 + wid * QBLK) * PO, shm, wid, lane, r32, hi);
  asm volatile("s_waitcnt vmcnt(0) lgkmcnt(0)\n\ts_barrier" ::: "memory");
#undef DMA_K
#undef DMA_V
}
#undef SBAR
#undef WAIT_BAR
}

#define XB_TMO      128
#define XB_XCNT(j)  (256  + 64 * (j))
#define XB_XSUB(j)  (1280 + 64 * (j))
#define XB_XGEN(j)  (2304 + 64 * (j))
#define XB_TOP      3328
#define XB_TOPGEN   3392
#define XCD_BAR_WORDS 3456
#define XB_SPIN_CAP (1u << 18)
__device__ __forceinline__ unsigned xb_ld(unsigned* p)              { return __hip_atomic_load(p, __ATOMIC_RELAXED, __HIP_MEMORY_SCOPE_AGENT); }
__device__ __forceinline__ unsigned xb_add(unsigned* p, unsigned v) { return __hip_atomic_fetch_add(p, v, __ATOMIC_RELAXED, __HIP_MEMORY_SCOPE_AGENT); }
__device__ __forceinline__ unsigned xb_xcc_id() { return (unsigned)__builtin_amdgcn_s_getreg((3 << 11) | 20) & 0xFu; }
#define XB_SPIN(cond, bar) do { unsigned _sp = 0; while (cond) { __builtin_amdgcn_s_sleep(1); \
    if ((++_sp & 255u) == 0u) { if (xb_ld(&(bar)[XB_TMO])) break; if (_sp > XB_SPIN_CAP) { atomicAdd(&(bar)[XB_TMO], 1u); break; } } } } while (0)
struct XcdBarrier { unsigned* bar; unsigned x; volatile LAS unsigned* st; };
__device__ __forceinline__ XcdBarrier xcd_barrier_post(unsigned* bar, volatile LAS unsigned* st) {
    XcdBarrier b; b.bar = bar; b.x = xb_xcc_id(); b.st = st;
    if (threadIdx.x == 0) (void)xb_add(&bar[XB_XCNT(b.x)], 1u);
    return b;
}
__device__ __forceinline__ void xcd_barrier_complete(unsigned* bar, unsigned x, unsigned& nloc, unsigned& nx) {
    const unsigned G = gridDim.x * gridDim.y * gridDim.z;
    unsigned sum, cnt, mine, sp = 0u;
    for (;;) {
        sum = 0u; cnt = 0u; mine = 0u;
#pragma unroll
        for (unsigned j = 0; j < 16; ++j) { const unsigned c = xb_ld(&bar[XB_XCNT(j)]); sum += c; cnt += (c > 0u) ? 1u : 0u; mine = (j == x) ? c : mine; }
        if (sum == G) break;
        __builtin_amdgcn_s_sleep(1);
        if ((++sp & 255u) == 0u) { if (xb_ld(&bar[XB_TMO])) break; if (sp > XB_SPIN_CAP) { atomicAdd(&bar[XB_TMO], 1u); break; } }
    }
    nloc = mine > 0u ? mine : 1u; nx = cnt > 0u ? cnt : 1u;
}
__device__ __forceinline__ void xcd_barrier(const XcdBarrier& b) {
    asm volatile("s_waitcnt vmcnt(0)" ::: "memory");
    __syncthreads();
    if (threadIdx.x == 0) {
        unsigned* bar = b.bar;
        __builtin_amdgcn_s_waitcnt(0);
        unsigned nloc = b.st[0], nx = b.st[1];
        if (nloc == 0u) { xcd_barrier_complete(bar, b.x, nloc, nx); b.st[0] = nloc; b.st[1] = nx; }
        const unsigned old = xb_add(&bar[XB_XSUB(b.x)], 1u);
        const unsigned gen = old / nloc;
        if (old + 1u == (gen + 1u) * nloc) {
            __builtin_amdgcn_fence(__ATOMIC_RELEASE, "agent");
            asm volatile("s_waitcnt vmcnt(0)" ::: "memory");
            const unsigned og = xb_add(&bar[XB_TOP], 1u);
            const unsigned tg = og / nx;
            if (og + 1u == (tg + 1u) * nx) xb_add(&bar[XB_TOPGEN], 1u);
            else XB_SPIN(xb_ld(&bar[XB_TOPGEN]) == tg, bar);
            __builtin_amdgcn_fence(__ATOMIC_ACQUIRE, "agent");
            xb_add(&bar[XB_XGEN(b.x)], 1u);
            asm volatile("s_waitcnt vmcnt(0)" ::: "memory");
        } else {
            XB_SPIN(xb_ld(&bar[XB_XGEN(b.x)]) == gen, bar);
            __builtin_amdgcn_fence(__ATOMIC_ACQUIRE, "agent");
            asm volatile("s_waitcnt vmcnt(0)" ::: "memory");
        }
    }
    __syncthreads();
}

struct Args { const float* in[24]; float* out; unsigned char* ws; };
struct Frame {
    LAS unsigned char* lds;
    int tid, lane, wave, vcu, G, bid;
};
#define CAS __attribute__((address_space(4)))
__device__ __forceinline__ const CAS char* karg_base() { const CAS char* p = (const CAS char*)__builtin_amdgcn_kernarg_segment_ptr(); asm volatile("" : "+s"(p)); return p; }
#define KIN(i) (*(const float* const CAS*)(karg_base() + 8 * (i)))
#define KOUT() (*(float* const CAS*)(karg_base() + 192))
#define KWS() (*(unsigned char* const CAS*)(karg_base() + 200))

__device__ __forceinline__ void p0_prologue(Frame& F) {
    const int gw = F.bid * NWAVES + F.wave, NGW = F.G * NWAVES, lane = F.lane;
    constexpr int N_GATE = 64 * 256, N_MOE = 3 * N_GATE, N_PROJ = 4 * 768, N_WOUT = 4 * 256, NITEMS = N_MOE + N_PROJ + N_WOUT;
    for (int it = gw; it < NITEMS; it += NGW) {
        const float* W; int pitch, nblk, item, kind; bf16_t* WT;
        if (it < N_MOE) { const int which = it / N_GATE, r = it % N_GATE, mat = r >> 8; item = r & 255; pitch = 1024; nblk = 16;
            W = KIN(21 + which) + (size_t)mat * 1048576;
            if (which < 2) { WT = (bf16_t*)(KWS() + WS_WGU) + (size_t)mat * 2097152; kind = 1 + which; } else { WT = (bf16_t*)(KWS() + WS_WD) + (size_t)mat * 1048576; kind = 0; } }
        else if (it < N_MOE + N_PROJ) { const int r = it - N_MOE, l = r / 768; item = r % 768; nblk = 48; kind = 3;
            if (l & 1) { W = KIN(12) + (size_t)(l >> 1) * 1024 * 3088; pitch = 3088; } else { W = KIN(3) + (size_t)(l >> 1) * 1024 * 3072; pitch = 3072; }
            WT = (bf16_t*)(KWS() + WS_WIN) + (size_t)l * 3145728; }
        else { const int r = it - N_MOE - N_PROJ, l = r >> 8; item = r & 255; nblk = 16; pitch = 1024; kind = 0;
            W = ((l & 1) ? KIN(16) : KIN(11)) + (size_t)(l >> 1) * 1048576; WT = (bf16_t*)(KWS() + WS_WOUT) + (size_t)l * 1048576; }
        const int nb = item % nblk, kb = item / nblk, n = nb * 64 + lane, k0 = kb * 64;
        int drow = n;
        if (kind == 1) drow = ((n >> 7) << 8) + (n & 127);
        else if (kind == 2) drow = ((n >> 7) << 8) + 128 + (n & 127);
        else if (kind == 3) { const int lb = (n >> 5) & 7, pb = 4 * (lb & 1) + (lb >> 1); drow = (n & ~255) + pb * 32 + (n & 31); }
        const float* src = W + (size_t)k0 * pitch + n;
        bf16_t* dst = WT + (size_t)drow * 1024 + k0;
#pragma unroll
        for (int h = 0; h < 2; ++h) {
            float v[32];
#pragma unroll
            for (int i = 0; i < 32; ++i) v[i] = src[(size_t)(h * 32 + i) * pitch];
#pragma unroll
            for (int c = 0; c < 4; ++c) { u32x4 w; w.x = cvt_pk_bf16(v[8 * c], v[8 * c + 1]); w.y = cvt_pk_bf16(v[8 * c + 2], v[8 * c + 3]); w.z = cvt_pk_bf16(v[8 * c + 4], v[8 * c + 5]); w.w = cvt_pk_bf16(v[8 * c + 6], v[8 * c + 7]);
                *(u32x4*)(dst + h * 32 + 8 * c) = w; }
        }
    }
}

__device__ __forceinline__ float reduce16(float (&v)[16], int lane) {
    { const bool b = (lane & 32) != 0;
#pragma unroll
      for (int i = 0; i < 8; ++i) { const float keep = b ? v[i + 8] : v[i], send = b ? v[i] : v[i + 8]; v[i] = keep + xor32_partner(send, b); } }
    { const bool b = (lane & 16) != 0;
#pragma unroll
      for (int i = 0; i < 4; ++i) { const float keep = b ? v[i + 4] : v[i], send = b ? v[i] : v[i + 4]; v[i] = keep + xor_swz<16>(send); } }
    { const bool b = (lane & 8) != 0;
#pragma unroll
      for (int i = 0; i < 2; ++i) { const float keep = b ? v[i + 2] : v[i], send = b ? v[i] : v[i + 2]; v[i] = keep + xor_swz<8>(send); } }
    { const bool b = (lane & 4) != 0; const float keep = b ? v[1] : v[0], send = b ? v[0] : v[1]; v[0] = keep + xor_swz<4>(send); }
    float r = v[0]; r += xor_swz<2>(r); r += xor_swz<1>(r); return r;
}
__device__ __forceinline__ float reduce4(float (&v)[4], int lane) {
    { const bool b = (lane & 32) != 0;
#pragma unroll
      for (int i = 0; i < 2; ++i) { const float keep = b ? v[i + 2] : v[i], send = b ? v[i] : v[i + 2]; v[i] = keep + xor32_partner(send, b); } }
    { const bool b = (lane & 16) != 0; const float keep = b ? v[1] : v[0], send = b ? v[0] : v[1]; v[0] = keep + xor_swz<16>(send); }
    float r = v[0]; r += xor_swz<8>(r); r += xor_swz<4>(r); r += xor_swz<2>(r); r += xor_swz<1>(r); return r;
}

struct RowArgs {
    const float* xin; float* xres; const float* gain; bf16_t* XN;
    const bf16_t* Y; const int* r_e; const int* r_rel; const float* r_w; const unsigned* cnt_prev;
    bool fgate; const float* wf; const float* bf; float* logf;
    const float* wr; const float* br; const float* wg; const float* bg;
    int* o_e; int* o_rel; float* o_w; unsigned* cnt; int* lists;
};
template <int MODE> __device__ __forceinline__ void row_phase(Frame& F, const RowArgs& R) {
    LAS float* wt = (LAS float*)F.lds;
    LAS int* rt_e = (LAS int*)(F.lds + 81920);
    LAS float* rt_w = (LAS float*)(F.lds + 81920 + 512);
    LAS int* rt_rank = (LAS int*)(F.lds + 81920 + 1024);
    LAS int* hist = (LAS int*)(F.lds + 81920 + 1536);
    LAS int* pbase = (LAS int*)(F.lds + MOETAB_OFF + 256);
    const int lane = F.lane, tid = F.tid;
    constexpr bool COMBINE = (MODE == 1 || MODE == 3), ROUTER = (MODE == 2), NORM = (MODE != 3);
    const bool fgate = (MODE <= 1) && R.fgate;
    if (ROUTER) {
        for (int k = tid; k < 1024; k += NWAVES * 64) {
            const f32x4* s = (const f32x4*)(R.wr + (size_t)k * 16);
#pragma unroll
            for (int q = 0; q < 4; ++q) { const f32x4 v = s[q]; wt[(4 * q) * 1024 + k] = v[0]; wt[(4 * q + 1) * 1024 + k] = v[1]; wt[(4 * q + 2) * 1024 + k] = v[2]; wt[(4 * q + 3) * 1024 + k] = v[3]; }
            const f32x4 g = *(const f32x4*)(R.wg + (size_t)k * 4); wt[16 * 1024 + k] = g[0]; wt[17 * 1024 + k] = g[1]; wt[18 * 1024 + k] = g[2]; wt[19 * 1024 + k] = g[3];
        }
        if (tid < 32) hist[tid] = 0;
    }
    if (fgate) {
        for (int k = tid; k < 1024; k += NWAVES * 64) {
            const f32x4* s = (const f32x4*)(R.wf + (size_t)k * 3088);
#pragma unroll
            for (int q = 0; q < 4; ++q) { const f32x4 v = s[q]; wt[(4 * q) * 1024 + k] = v[0]; wt[(4 * q + 1) * 1024 + k] = v[1]; wt[(4 * q + 2) * 1024 + k] = v[2]; wt[(4 * q + 3) * 1024 + k] = v[3]; }
        }
    }
    if (COMBINE) {
        if (tid == 0) { int acc = 0; for (int e = 0; e < 16; ++e) { pbase[e] = acc; acc += (((int)R.cnt_prev[e] + 255) >> 8) << 8; } }
    }
    __syncthreads();
    f32x4 g4[4];
    if (NORM) {
#pragma unroll
        for (int j = 0; j < 4; ++j) g4[j] = *(const f32x4*)(R.gain + 4 * lane + 256 * j);
    }
    for (int blk = F.bid; blk < M / 64; blk += F.G) {
#pragma unroll 1
        for (int rr = 0; rr < 8; ++rr) {
            const int lrow = F.wave * 8 + rr, row = blk * 64 + lrow;
            const f32x4* xr = (const f32x4*)((MODE == 0 ? R.xin : (const float*)R.xres) + (size_t)row * DM) + lane;
            f32x4 x4[4];
#pragma unroll
            for (int j = 0; j < 4; ++j) x4[j] = xr[64 * j];
            if (COMBINE) {
#pragma unroll
                for (int k = 0; k < 2; ++k) {
                    const int e = R.r_e[row * 2 + k], rel = R.r_rel[row * 2 + k]; const float w = R.r_w[row * 2 + k];
                    const size_t pos = (size_t)(pbase[e] + rel);
                    const u32x2* yr = (const u32x2*)(R.Y + pos * DM) + lane;
#pragma unroll
                    for (int j = 0; j < 4; ++j) { const u32x2 y = yr[64 * j]; x4[j][0] += w * bf_lo(y.x); x4[j][1] += w * bf_hi(y.x); x4[j][2] += w * bf_lo(y.y); x4[j][3] += w * bf_hi(y.y); }
                }
            }
            if (MODE != 2) { f32x4* xo = (f32x4*)(R.xres + (size_t)row * DM) + lane;
#pragma unroll
                for (int j = 0; j < 4; ++j) xo[64 * j] = x4[j]; }
            if (NORM) {
                float ss = 0.f;
#pragma unroll
                for (int j = 0; j < 4; ++j) ss += (x4[j][0] * x4[j][0] + x4[j][1] * x4[j][1]) + (x4[j][2] * x4[j][2] + x4[j][3] * x4[j][3]);
                const float rstd = __builtin_amdgcn_rsqf(wave_sum(ss) * (1.f / DM) + EPS);
#pragma unroll
                for (int j = 0; j < 4; ++j) x4[j] = x4[j] * rstd * g4[j];
                u32x2* xo = (u32x2*)(R.XN + (size_t)row * DM) + lane;
#pragma unroll
                for (int j = 0; j < 4; ++j) { u32x2 w; w.x = cvt_pk_bf16(x4[j][0], x4[j][1]); w.y = cvt_pk_bf16(x4[j][2], x4[j][3]); xo[64 * j] = w; }
                if (fgate || ROUTER) {
                    float d[16];
#pragma unroll
                    for (int c = 0; c < 16; ++c) { float a = 0.f;
#pragma unroll
                        for (int j = 0; j < 4; ++j) { const f32x4 w = *(const LAS f32x4*)(wt + c * 1024 + 256 * j + 4 * lane); a += (x4[j][0] * w[0] + x4[j][1] * w[1]) + (x4[j][2] * w[2] + x4[j][3] * w[3]); }
                        d[c] = a; }
                    const float rl = reduce16(d, lane);
                    if (fgate) {
                        const int h = lane >> 2; const float z = rl + R.bf[h];
                        const float ls = fminf(z, 0.f) - 0.6931471805599453f * __builtin_amdgcn_logf(1.f + __builtin_amdgcn_exp2f(-fabsf(z) * LOG2E));
                        if ((lane & 3) == 0) R.logf[(size_t)row * 16 + h] = ls;
                    }
                    if (ROUTER) {
                        float dg[4];
#pragma unroll
                        for (int c = 0; c < 4; ++c) { float a = 0.f;
#pragma unroll
                            for (int j = 0; j < 4; ++j) { const f32x4 w = *(const LAS f32x4*)(wt + (16 + c) * 1024 + 256 * j + 4 * lane); a += (x4[j][0] * w[0] + x4[j][1] * w[1]) + (x4[j][2] * w[2] + x4[j][3] * w[3]); }
                            dg[c] = a; }
                        const float gl_ = reduce4(dg, lane);
                        float gl[4];
#pragma unroll
                        for (int c = 0; c < 4; ++c) gl[c] = __int_as_float(__builtin_amdgcn_readlane(__float_as_int(gl_), 16 * c)) + R.bg[c];
                        int gi = 0; float gm = gl[0];
#pragma unroll
                        for (int c = 1; c < 4; ++c) if (gl[c] > gm) { gm = gl[c]; gi = c; }
                        float gs = 0.f;
#pragma unroll
                        for (int c = 0; c < 4; ++c) gs += __builtin_amdgcn_exp2f((gl[c] - gm) * LOG2E);
                        const float gw = __builtin_amdgcn_rcpf(gs);
                        gi = __builtin_amdgcn_readfirstlane(gi);
                        float el[4];
#pragma unroll
                        for (int c = 0; c < 4; ++c) el[c] = __int_as_float(__builtin_amdgcn_readlane(__float_as_int(rl), 4 * (4 * gi + c))) + R.br[4 * gi + c];
                        int i0 = 0; float v0 = el[0];
#pragma unroll
                        for (int c = 1; c < 4; ++c) if (el[c] > v0) { v0 = el[c]; i0 = c; }
                        int i1 = -1; float v1 = -INFINITY;
#pragma unroll
                        for (int c = 0; c < 4; ++c) if (c != i0 && el[c] > v1) { v1 = el[c]; i1 = c; }
                        const float p0 = __builtin_amdgcn_rcpf(1.f + __builtin_amdgcn_exp2f((v1 - v0) * LOG2E));
                        if (lane == 0) { rt_e[2 * lrow] = 4 * gi + i0; rt_e[2 * lrow + 1] = 4 * gi + i1; rt_w[2 * lrow] = p0 * gw; rt_w[2 * lrow + 1] = (1.f - p0) * gw; }
                    }
                }
            }
        }
        if (ROUTER) {
            __syncthreads();
            int e = 0;
            if (tid < 128) { e = rt_e[tid]; rt_rank[tid] = atomicAdd((int*)(hist + e), 1); }
            __syncthreads();
            if (tid < 16) hist[16 + tid] = (int)atomicAdd(R.cnt + tid, (unsigned)hist[tid]);
            __syncthreads();
            if (tid < 128) { const int row = blk * 64 + (tid >> 1), k = tid & 1, rel = hist[16 + e] + rt_rank[tid];
                R.o_e[row * 2 + k] = e; R.o_rel[row * 2 + k] = rel; R.o_w[row * 2 + k] = rt_w[tid]; R.lists[e * LISTCAP + rel] = row; }
            __syncthreads();
            if (tid < 16) hist[tid] = 0;
            __syncthreads();
        }
    }
}

__device__ __forceinline__ void cumsum_phase(Frame& F, const float* logf, float* ftabg, int* jsg, float T) {
    LAS float* tot = (LAS float*)F.lds;
    LAS float* fl = (LAS float*)(F.lds + 4096);
    for (int bh = F.bid; bh < 32; bh += F.G) {
        const int b = bh >> 4, h = bh & 15, t0 = F.tid * 16;
        float v[16]; float run = 0.f;
#pragma unroll
        for (int j = 0; j < 16; ++j) { run += logf[(size_t)(b * SEQ + t0 + j) * 16 + h]; v[j] = run; }
        tot[F.tid] = run;
        __syncthreads();
        if (F.tid < 8) { float a = 0.f; for (int j = 0; j < 64; ++j) a += tot[F.tid * 64 + j]; tot[512 + F.tid] = a; }
        __syncthreads();
        float base = 0.f;
        for (int w = 0; w < F.wave; ++w) base += tot[512 + w];
        for (int j = 0; j < 63; ++j) { const float u = tot[F.wave * 64 + j]; base += (j < F.lane) ? u : 0.f; }
        float* dst = ftabg + (size_t)bh * SEQ + t0;
#pragma unroll
        for (int j = 0; j < 16; j += 4) { const f32x4 o = (f32x4){(base + v[j]) * LOG2E, (base + v[j + 1]) * LOG2E, (base + v[j + 2]) * LOG2E, (base + v[j + 3]) * LOG2E};
            *(f32x4*)(dst + j) = o; *(LAS f32x4*)(fl + t0 + j) = o; }
        __syncthreads();
        if (F.tid < 32) { const int qb = F.tid, nt = 4 * qb + 4; const float lim = fl[256 * qb] + T; int js = 0;
            while (js < nt - 4 && fl[64 * js + 63] > lim) ++js;
            jsg[bh * 32 + qb] = js & ~1; }
        __syncthreads();
    }
}

__device__ __forceinline__ void acombine_phase(Frame& F, const bf16_t* AO, bf16_t* O, const float* lq1, const float* lk1, const float* lq2, const float* lk2, const float* subg, float lam_init) {
    const int lane = F.lane;
    const float s1 = wave_sum(lq1[lane] * lk1[lane]), s2 = wave_sum(lq2[lane] * lk2[lane]);
    const float lam = __builtin_amdgcn_exp2f(s1 * LOG2E) - __builtin_amdgcn_exp2f(s2 * LOG2E) + lam_init, osc = 1.f - lam_init;
    const int hA = lane >> 4, j0 = (lane & 15) * 8;
    float g[8];
#pragma unroll
    for (int i = 0; i < 8; ++i) g[i] = subg[j0 + i] * osc;
    const int gw = F.bid * NWAVES + F.wave, NGW = F.G * NWAVES;
    for (int row = gw; row < M; row += NGW) {
        const u32x4 a = *(const u32x4*)(AO + (size_t)row * DM + hA * 256 + j0), b = *(const u32x4*)(AO + (size_t)row * DM + hA * 256 + 128 + j0);
        float d[8];
        d[0] = bf_lo(a.x) - lam * bf_lo(b.x); d[1] = bf_hi(a.x) - lam * bf_hi(b.x); d[2] = bf_lo(a.y) - lam * bf_lo(b.y); d[3] = bf_hi(a.y) - lam * bf_hi(b.y);
        d[4] = bf_lo(a.z) - lam * bf_lo(b.z); d[5] = bf_hi(a.z) - lam * bf_hi(b.z); d[6] = bf_lo(a.w) - lam * bf_lo(b.w); d[7] = bf_hi(a.w) - lam * bf_hi(b.w);
        float ss = 0.f;
#pragma unroll
        for (int i = 0; i < 8; ++i) ss += d[i] * d[i];
        ss += xor_swz<1>(ss); ss += xor_swz<2>(ss); ss += xor_swz<4>(ss); ss += xor_swz<8>(ss);
        const float rstd = __builtin_amdgcn_rsqf(ss * (1.f / 128.f) + EPS);
        u32x4 w; w.x = cvt_pk_bf16(d[0] * rstd * g[0], d[1] * rstd * g[1]); w.y = cvt_pk_bf16(d[2] * rstd * g[2], d[3] * rstd * g[3]);
        w.z = cvt_pk_bf16(d[4] * rstd * g[4], d[5] * rstd * g[5]); w.w = cvt_pk_bf16(d[6] * rstd * g[6], d[7] * rstd * g[7]);
        *(u32x4*)(O + (size_t)row * DM + hA * 128 + j0) = w;
    }
}

__global__ void __launch_bounds__(NWAVES * 64, 2) hybrid_fwd(Args args_unused) {
    extern __shared__ __attribute__((aligned(16))) unsigned char lds[];
    Frame F;
    F.lds = (LAS unsigned char*)lds;
    const int wave_s = __builtin_amdgcn_readfirstlane((int)threadIdx.x >> 6);
    F.tid = threadIdx.x; F.lane = F.tid & 63; F.wave = wave_s;
    F.G = gridDim.x; F.bid = blockIdx.x; { const int bx = blockIdx.x; F.vcu = (F.G % 8 == 0) ? (bx % 8) * (F.G / 8) + bx / 8 : bx; }
#define WSB KWS()
#define CTLP ((unsigned*)(KWS() + WS_CTL))
    volatile LAS unsigned* MISC = (volatile LAS unsigned*)(F.lds + MISC_OFF);
    for (int u = F.tid; u < (LDS_BYTES - LDSCTL_OFF) / 4; u += NWAVES * 64) ((LAS unsigned*)(F.lds + LDSCTL_OFF))[u] = 0u;
    __syncthreads();
    (void)xcd_barrier_post(CTLP + CW_BAR, MISC + 8);
#define RELAUNDER() do { int l_; asm volatile("v_mbcnt_lo_u32_b32 %0, -1, 0\n\tv_mbcnt_hi_u32_b32 %0, -1, %0" : "=&v"(l_)); F.lane = l_; F.tid = wave_s * 64 + l_; F.wave = wave_s; } while (0)
#define FRESH_TID(var) int var; do { int l_; asm volatile("v_mbcnt_lo_u32_b32 %0, -1, 0\n\tv_mbcnt_hi_u32_b32 %0, -1, %0" : "=&v"(l_)); var = wave_s * 64 + l_; } while (0)
#define GRID_BAR() do { XcdBarrier b_; b_.bar = CTLP + CW_BAR; b_.x = xb_xcc_id(); b_.st = MISC + 8; xcd_barrier(b_); RELAUNDER(); } while (0)

#define P_XN ((bf16_t*)(WSB + WS_XN))
#define P_QKV ((bf16_t*)(WSB + WS_QKV))
#define P_OB ((bf16_t*)(WSB + WS_O))
#define P_AO ((bf16_t*)(WSB + WS_AO))
#define P_HB ((bf16_t*)(WSB + WS_H))
#define P_YB ((bf16_t*)(WSB + WS_Y))
#define P_FTABG ((float*)(WSB + WS_FTAB))
#define P_LOGF ((float*)(WSB + WS_LOGF))
#define P_RE ((int*)(WSB + WS_ROUTE))
#define P_RREL (P_RE + 2 * M)
#define P_RW ((float*)(P_RREL + 2 * M))
#define P_LISTS ((int*)(WSB + WS_LISTS))
    LAS float* gtab = (LAS float*)(F.lds + GTAB_OFF);
    LAS int* moetab = (LAS int*)(F.lds + MOETAB_OFF);

    for (int rep_ = 0; rep_ < REP_P0; ++rep_) p0_prologue(F);
    GRID_BAR();

#pragma unroll 1
    for (int layer = 0; layer < DEPTH; ++layer) {
        const int li = layer >> 1; const bool odd = (layer & 1) != 0;
        {
            RowArgs R{};
            R.xin = KIN(0); R.xres = KOUT(); R.gain = KIN(1) + layer * DM; R.XN = P_XN;
            R.Y = P_YB; R.r_e = P_RE; R.r_rel = P_RREL; R.r_w = P_RW; R.cnt_prev = CTLP + CW_CNT + 64 * (layer > 0 ? layer - 1 : 0);
            R.fgate = odd; R.wf = KIN(12) + (size_t)li * 1024 * 3088 + 3072; R.bf = KIN(13) + li * 16; R.logf = P_LOGF;
            if (layer == 0) row_phase<0>(F, R); else row_phase<1>(F, R);
        }
        GRID_BAR();
        {
            if (odd) { const float* gq = KIN(14) + li * 64; const float* gk = KIN(15) + li * 64;
                const float Bp = 1.03f * 8.f * wave_max(fabsf(gq[F.lane])) * wave_max(fabsf(gk[F.lane])) * LOG2E + 0.5f;
                cumsum_phase(F, P_LOGF, P_FTABG, (int*)(WSB + WS_JS), 2.f * Bp + 152.f); }
            if (F.tid < 128) { const float* gq = odd ? KIN(14) + li * 64 : KIN(4) + li * 64; const float* gk = odd ? KIN(15) + li * 64 : KIN(5) + li * 64;
                gtab[F.tid] = F.tid < 64 ? gq[F.tid] * C2 : gk[F.tid - 64]; }
            __syncthreads();
            pg8::ProjSched S; S.so.init(M, NQKV, F.G, F.bid); S.A = (const char*)P_XN; S.W = (const char*)(WSB + WS_WIN) + (size_t)layer * 3145728 * 2;
            if (odd) { S.mq = 4; S.mk = 8; S.s_lo = 0; S.s_hi = 0; } else { S.mq = 2; S.mk = 4; S.s_lo = 6; S.s_hi = 8; }
            pg8::EpiProj E{P_QKV, gtab};
            for (int rep_ = 0; rep_ < REP_PROJ; ++rep_) { int t_ = F.tid; asm volatile("" : "+v"(t_)); pg8::gemm_phase<pg8::EpiProj, pg8::ProjSched, false>(F.lds, S, E, t_); }
        }
        GRID_BAR();
        {
            using abf = att::bf16;
            const float* gq = odd ? KIN(14) + li * 64 : KIN(4) + li * 64; const float* gk = odd ? KIN(15) + li * 64 : KIN(5) + li * 64;
            const float Bp = 1.03f * 8.f * wave_max(fabsf(gq[F.lane])) * wave_max(fabsf(gk[F.lane])) * LOG2E + 0.5f;
            LAS float* ftab = (LAS float*)(F.lds + att::LDS_FTAB);
            LAS int* jsl = (LAS int*)(F.lds + JSL_OFF);
            const float Tskip = 2.f * Bp + 152.f;
            if (odd) { const int* jsg = (const int*)(WSB + WS_JS); for (int i = F.tid; i < 1024; i += NWAVES * 64) jsl[i] = jsg[i]; }
            else { for (int i = F.tid; i < 1024; i += NWAVES * 64) { const int vh = i >> 5, qb = i & 31, hA = (vh >> 2) & 3;
                    const float slope = __builtin_amdgcn_exp2f(-2.f * (float)(hA + 1)) * LOG2E;
                    const float jf = ((float)(256 * qb - 63) - Tskip / slope) * (1.f / 64.f);
                    int js = jf > 0.f ? (int)jf : 0; js = js < 4 * qb ? js : 4 * qb; jsl[i] = js & ~1; } }
            __syncthreads();
            LAS unsigned short* perm = (LAS unsigned short*)(F.lds + PERM_OFF);
            for (int e = F.tid; e < 1024; e += NWAVES * 64) { const int x = e >> 7, r = e & 127, hb = (x >> 2) * 16 + (x & 3);
                const int vh = hb + 4 * (r >> 5), qb = r & 31, cost = 4 * qb - jsl[vh * 32 + qb]; int rank = 0;
                for (int r2 = 0; r2 < 128; ++r2) { const int c2 = 4 * (r2 & 31) - jsl[(hb + 4 * (r2 >> 5)) * 32 + (r2 & 31)]; rank += (c2 > cost || (c2 == cost && r2 < r)) ? 1 : 0; }
                perm[x * 128 + rank] = (unsigned short)((vh << 5) | qb); }
            __syncthreads();
            const int home = (int)(xb_xcc_id() & 7u);
            const int nrep_att = odd ? REP_ATT_ODD : REP_ATT_EVEN;
            for (int rep_ = 0; rep_ < nrep_att; ++rep_) {
                if (rep_ > 0) { GRID_BAR(); }
                unsigned* qh = CTLP + CW_ATTQ + (layer * 2 + rep_) * 512;
#pragma unroll 1
                for (int kk = 0; kk < 8; ++kk) { const int x = (home + kk) & 7;
                    if (kk > 0) {
                        FRESH_TID(tq);
                        if (tq < 8) MISC[24 + tq] = xb_ld(qh + 64 * tq);
                        __syncthreads();
                        bool any = false;
#pragma unroll
                        for (int q = 0; q < 8; ++q) any = any || (MISC[24 + q] < 128u);
                        const bool mine = MISC[24 + x] < 128u;
                        __syncthreads();
                        if (!any) break;
                        if (!mine) continue;
                    }
#pragma unroll 1
                    for (;;) {
                        FRESH_TID(tf);
                        if (tf == 0) MISC[16] = xb_add(qh + 64 * x, 1u);
                        __syncthreads();
                        const int i = (int)MISC[16];
                        __syncthreads();
                        if (i >= 128) break;
                        const int ent = __builtin_amdgcn_readfirstlane((int)perm[x * 128 + i]), vh = ent >> 5, qb = ent & 31;
                        const int js = __builtin_amdgcn_readfirstlane(jsl[vh * 32 + qb]);
                        const int b = vh >> 4;
                        const abf *Qh, *Kh, *Vh; abf* Oh;
                        const abf* base = (const abf*)P_QKV + (size_t)b * SEQ * PQ;
                        if (odd) { const int h = vh & 15; Qh = base + h * 64; Kh = base + 1024 + h * 64; Vh = base + 2048 + h * 64; Oh = (abf*)P_OB + (size_t)b * SEQ * DM + h * 64;
                            const f32x4* src = (const f32x4*)(P_FTABG + (size_t)vh * SEQ);
                            for (int j = 16 * js + tf; j < 64 * qb + 64; j += NWAVES * 64) ((LAS f32x4*)ftab)[j] = src[j];
                        } else { const int hA = (vh >> 2) & 3, mp = (vh >> 1) & 1, vhalf = vh & 1;
                            Qh = base + hA * 128 + mp * 64; Kh = base + 512 + hA * 128 + mp * 64; Vh = base + 1024 + hA * 128 + vhalf * 64; Oh = (abf*)P_AO + (size_t)b * SEQ * DM + hA * 256 + mp * 128 + vhalf * 64;
                            const float slope = __builtin_amdgcn_exp2f(-2.f * (float)(hA + 1)) * LOG2E;
                            for (int j = 64 * js + tf; j < 256 * qb + 256; j += NWAVES * 64) ftab[j] = -slope * (float)j;
                        }
                        __syncthreads();
                        { FRESH_TID(t_); att::attn_unit_b<DM>(qb, js, Qh, Kh, Vh, Oh, Bp, (char*)lds, t_); }
                    }
                }
            }
            if (!odd) {
                for (int rep_ = 0; rep_ < REP_SB; ++rep_)
#pragma unroll 1
                for (int u = F.vcu; u < 512; u += F.G) {
                    const int uu = (u & 255) * 2 + (u >> 8);
                    const int bh = uu >> 5, qb = uu & 31, b = bh >> 3, hB = bh & 7;
                    const abf* base = (const abf*)P_QKV + (size_t)b * SEQ * PQ;
                    FRESH_TID(t_);
                    att::sb_unit<DM>(qb, base + 1536 + hB * 64, base + 2048 + hB * 64, base + 2560 + hB * 64, (abf*)P_OB + (size_t)b * SEQ * DM + 512 + hB * 64, (char*)lds, t_);
                }
            }
        }
        GRID_BAR();
        if (!odd) {
            const float lam_init = 0.8f - 0.6f * __builtin_amdgcn_exp2f(-0.3f * LOG2E * (float)layer);
            for (int rep_ = 0; rep_ < REP_ACOMB; ++rep_) acombine_phase(F, P_AO, P_OB, KIN(6) + li * 64, KIN(7) + li * 64, KIN(8) + li * 64, KIN(9) + li * 64, KIN(10) + li * 128, lam_init);
            GRID_BAR();
        }
        {
            pg8::WoutSched S; S.so.init(M, DM, F.G, F.bid); S.A = (const char*)P_OB; S.W = (const char*)(WSB + WS_WOUT) + (size_t)layer * 1048576 * 2;
            pg8::EpiResid E{KOUT()};
            pg8::gemm_phase<pg8::EpiResid, pg8::WoutSched, false>(F.lds, S, E, F.tid);
        }
        GRID_BAR();
        {
            RowArgs R{};
            R.xin = KIN(0); R.xres = KOUT(); R.gain = KIN(2) + layer * DM; R.XN = P_XN;
            R.wr = KIN(19) + (size_t)layer * 1024 * 16; R.br = KIN(20) + layer * 16; R.wg = KIN(17) + (size_t)layer * 1024 * 4; R.bg = KIN(18) + layer * 4;
            R.o_e = P_RE; R.o_rel = P_RREL; R.o_w = P_RW; R.cnt = CTLP + CW_CNT + 64 * layer; R.lists = P_LISTS;
            row_phase<2>(F, R);
        }
        GRID_BAR();
        {
            if (F.tid == 0) { int acc = 0; for (int e = 0; e < 16; ++e) { const int c = (int)CTLP[CW_CNT + 64 * layer + e]; moetab[e] = acc; moetab[17 + e] = c; acc += (c + 255) >> 8; } moetab[16] = acc; }
            __syncthreads();
            pg8::MoeSched<8, true> S{moetab, F.G, F.bid, (const char*)P_XN, (const char*)(WSB + WS_WGU) + (size_t)layer * 16 * 2097152 * 2, P_LISTS};
            pg8::EpiSwiGLU E{P_HB};
            for (int rep_ = 0; rep_ < REP_UP; ++rep_) pg8::gemm_phase<pg8::EpiSwiGLU, pg8::MoeSched<8, true>, true>(F.lds, S, E, F.tid);
        }
        GRID_BAR();
        {
            pg8::MoeSched<4, false> S{moetab, F.G, F.bid, (const char*)P_HB, (const char*)(WSB + WS_WD) + (size_t)layer * 16 * 1048576 * 2, P_LISTS};
            pg8::EpiBf16 E{P_YB};
            for (int rep_ = 0; rep_ < REP_DOWN; ++rep_) pg8::gemm_phase<pg8::EpiBf16, pg8::MoeSched<4, false>, false>(F.lds, S, E, F.tid);
        }
        GRID_BAR();
    }
    {
        RowArgs R{};
        R.xin = KIN(0); R.xres = KOUT(); R.gain = KIN(1); R.XN = P_XN;
        R.Y = P_YB; R.r_e = P_RE; R.r_rel = P_RREL; R.r_w = P_RW; R.cnt_prev = CTLP + CW_CNT + 64 * (DEPTH - 1);
        row_phase<3>(F, R);
    }
    if (xb_ld(CTLP + CW_BAR + XB_TMO) != 0u) {
        VM_WAIT(); __syncthreads();
        const float qn = __builtin_nanf("");
        for (size_t i = (size_t)F.bid * 512 + F.tid; i < (size_t)M * DM; i += (size_t)F.G * 512) KOUT()[i] = qn;
    }
#undef GRID_BAR
}

#undef P_XN
#undef P_QKV
#undef P_OB
#undef P_AO
#undef P_HB
#undef P_YB
#undef P_FTABG
#undef P_LOGF
#undef P_RE
#undef P_RREL
#undef P_RW
#undef P_LISTS
#undef WSB
#undef CTLP
extern "C" void kernel_launch(void* const* d_in, const int* in_sizes, int n_in, void* d_out, int out_size, void* d_ws, size_t ws_size, hipStream_t stream) {
    static int grid = 0;
    if (grid == 0) {
        if (n_in != 24 || in_sizes[0] != M * DM || out_size != M * DM || ws_size < WS_END) { fprintf(stderr, "kernel_launch: unexpected shapes (n_in %d, in0 %d, out %d, ws %zu); nothing launched\n", n_in, n_in > 0 ? in_sizes[0] : -1, out_size, ws_size); grid = -1; return; }
        int dev = 0, cus = 0, per_cu = 0;
        if (hipGetDevice(&dev) != hipSuccess || hipDeviceGetAttribute(&cus, hipDeviceAttributeMultiprocessorCount, dev) != hipSuccess) { grid = -1; return; }
        if (hipFuncSetAttribute((const void*)hybrid_fwd, hipFuncAttributeMaxDynamicSharedMemorySize, LDS_BYTES) != hipSuccess) { fprintf(stderr, "kernel_launch: hipFuncSetAttribute failed\n"); grid = -1; return; }
        if (hipOccupancyMaxActiveBlocksPerMultiprocessor(&per_cu, (const void*)hybrid_fwd, NWAVES * 64, LDS_BYTES) != hipSuccess || per_cu < 1)
            fprintf(stderr, "kernel_launch: note: occupancy query reports %d workgroups per CU\n", per_cu);
        (void)hipGetLastError();
        grid = cus;
        if (grid != 256) fprintf(stderr, "kernel_launch: %d CUs; the attention schedule assumes 256\n", grid);
    }
    if (grid < 0) return;
    if (hipMemsetAsync((char*)d_ws + WS_CTL, 0, CTL_ZERO_BYTES, stream) != hipSuccess) return;
    Args a{};
    for (int i = 0; i < 24; ++i) a.in[i] = (const float*)d_in[i];
    a.out = (float*)d_out; a.ws = (unsigned char*)d_ws;
    hipLaunchKernelGGL(hybrid_fwd, dim3(grid), dim3(NWAVES * 64), LDS_BYTES, stream, a);
}
```
